# Optimizing an MI355X kernel written in HIP

```python
import math
import jax, jax.numpy as jnp
from jax import lax
import numpy as np

D_MODEL = 1024
BATCH = 1
SEQ = 16384
DEPTH = 1

GRID_W = 64
CTX_LEN = 256
S5_GROUP = 16
S5_GROUPS = 32
S5_WIDTH = S5_GROUP * S5_GROUPS
S5_STATE = 64
DT_MIN = 0.001
DT_MAX = 0.1
FFT_GROUPS = 4
FFT_GROUP_DIM = 128
FFT_WIDTH = FFT_GROUPS * FFT_GROUP_DIM
N_BRANCHES = 2
IN_WIDTH = S5_WIDTH + FFT_WIDTH + N_BRANCHES * D_MODEL
N_EXPERTS = 32
TOP_K = 4
D_EXPERT = D_MODEL
SWIGLU_ALPHA = 1.702
SWIGLU_LIMIT = 7.0
MOE_BLOCK = 128
LN_EPS = 1e-5
DEEPNORM_ALPHA = (2.0 * DEPTH) ** 0.25
DEEPNORM_BETA = (8.0 * DEPTH) ** -0.25

kernel_name = "s5_fnet_gated_moe_deepnorm_block"

F32 = jnp.float32


def layer_norm(x, g, b):
    xf = x.astype(F32)
    mu = jnp.mean(xf, axis=-1, keepdims=True)
    var = jnp.mean(jnp.square(xf - mu), axis=-1, keepdims=True)
    return ((xf - mu) * lax.rsqrt(var + LN_EPS) * g.astype(F32) + b.astype(F32)).astype(x.dtype)


def modulate(x, shift, scale):
    return x * (1 + scale) + shift


def sincos_2d(n_tokens, dtype):
    rows = n_tokens // GRID_W
    r, col = jnp.meshgrid(jnp.arange(rows, dtype=F32), jnp.arange(GRID_W, dtype=F32), indexing='ij')
    q = D_MODEL // 4
    omega = 1.0 / (10000.0 ** (jnp.arange(q, dtype=F32) / q))

    def emb(pos):
        ang = pos.reshape(-1)[:, None] * omega[None, :]
        return jnp.concatenate([jnp.sin(ang), jnp.cos(ang)], axis=-1)

    return jnp.concatenate([emb(r), emb(col)], axis=-1).astype(dtype)


def s5_discretise(lam_re, lam_im, log_dt, b_re, b_im):
    lam_re = lam_re.astype(F32)
    lam_im = lam_im.astype(F32)
    dt = jnp.exp(log_dt.astype(F32))[..., None]
    mag = jnp.exp(lam_re * dt)
    a_re = mag * jnp.cos(lam_im * dt)
    a_im = mag * jnp.sin(lam_im * dt)
    den = lam_re * lam_re + lam_im * lam_im
    num_re = a_re - 1.0
    k_re = (num_re * lam_re + a_im * lam_im) / den
    k_im = (a_im * lam_re - num_re * lam_im) / den
    b_re = b_re.astype(F32)
    b_im = b_im.astype(F32)
    bb_re = k_re[..., None] * b_re - k_im[..., None] * b_im
    bb_im = k_re[..., None] * b_im + k_im[..., None] * b_re
    return a_re, a_im, bb_re, bb_im


def complex_affine_combine(e1, e2):
    a1r, a1i, b1r, b1i = e1
    a2r, a2i, b2r, b2i = e2
    return (a2r * a1r - a2i * a1i,
            a2r * a1i + a2i * a1r,
            a2r * b1r - a2i * b1i + b2r,
            a2r * b1i + a2i * b1r + b2i)


def s5_direction(bu_re, bu_im, a_re, a_im, s0_re, s0_im, reverse):
    ar = jnp.broadcast_to(a_re, bu_re.shape)
    ai = jnp.broadcast_to(a_im, bu_re.shape)
    cr, ci, sr, si = lax.associative_scan(complex_affine_combine, (ar, ai, bu_re, bu_im),
                                          reverse=reverse, axis=1)
    s_re = sr + cr * s0_re[:, None] - ci * s0_im[:, None]
    s_im = si + cr * s0_im[:, None] + ci * s0_re[:, None]
    return s_re, s_im


def s5_states(u, s0, a_re, a_im, bb_re, bb_im):
    bsz, n, _ = u.shape
    ug = u.astype(F32).reshape(bsz, n, S5_GROUPS, S5_GROUP)
    states = []
    for d, reverse in ((0, False), (1, True)):
        bu_re = jnp.einsum('gph,blgh->blgp', bb_re[d], ug)
        bu_im = jnp.einsum('gph,blgh->blgp', bb_im[d], ug)
        states.append(s5_direction(bu_re, bu_im, a_re[d], a_im[d], s0[d][0], s0[d][1], reverse))
    return states


def s5_readout(states, u, c_re, c_im, d_skip):
    bsz, n, _ = u.shape
    y = u.astype(F32) * d_skip.astype(F32)
    for d, (s_re, s_im) in enumerate(states):
        yd = (jnp.einsum('ghp,blgp->blgh', c_re[d].astype(F32), s_re)
              - jnp.einsum('ghp,blgp->blgh', c_im[d].astype(F32), s_im))
        y = y + yd.reshape(bsz, n, S5_WIDTH)
    return y.astype(u.dtype)


def s5_branch(y, w_glu, b_glu, w_br):
    z = jax.nn.gelu(y) @ w_glu + b_glu
    z_a, z_b = jnp.split(z, 2, axis=-1)
    return (z_a * jax.nn.sigmoid(z_b)) @ w_br


def fourier_branch(u, w_br, b_br):
    bsz, n, _ = u.shape
    z = jnp.fft.fft2(u.astype(F32).reshape(bsz, n, FFT_GROUPS, FFT_GROUP_DIM), axes=(1, 3), norm='ortho')
    zr = jnp.real(z).reshape(bsz, n, FFT_WIDTH).astype(u.dtype)
    return zr @ w_br + b_br


def merge_branches(y_s5, y_fft, g_logits, w_out, b_out):
    g_s5, g_fft = jnp.split(jax.nn.sigmoid(g_logits), N_BRANCHES, axis=-1)
    return (g_s5 * y_s5 + g_fft * y_fft) @ w_out + b_out


def expert_ffn(xb, w_up, b_up, w_down, b_down):
    h = xb @ w_up + b_up
    h_glu, h_lin = jnp.split(h, 2, axis=-1)
    h_glu = jnp.minimum(h_glu, SWIGLU_LIMIT)
    h_lin = jnp.clip(h_lin, -SWIGLU_LIMIT, SWIGLU_LIMIT)
    return (h_glu * jax.nn.sigmoid(SWIGLU_ALPHA * h_glu) * (h_lin + 1)) @ w_down + b_down


def moe(h, w_router, b_router, w_up, b_up, w_down, b_down):
    n_tok, d = h.shape
    logits = (h @ w_router + b_router).astype(F32)
    top_val, top_idx = lax.top_k(logits, TOP_K)
    gate = jax.nn.softmax(top_val, axis=-1).astype(h.dtype)
    m = n_tok * TOP_K
    e = top_idx.reshape(m)
    order = jnp.argsort(e)
    e_sorted = e[order]
    tok_sorted = order // TOP_K
    w_sorted = gate.reshape(m)[order]
    counts = jnp.zeros((N_EXPERTS,), jnp.int32).at[e].add(1)
    starts = jnp.cumsum(counts) - counts
    padded = (counts + MOE_BLOCK - 1) // MOE_BLOCK * MOE_BLOCK
    pad_ends = jnp.cumsum(padded)
    pad_starts = pad_ends - padded
    dest = pad_starts[e_sorted] + (jnp.arange(m, dtype=jnp.int32) - starts[e_sorted])
    n_blocks = (m + MOE_BLOCK - 1) // MOE_BLOCK + N_EXPERTS
    rows = n_blocks * MOE_BLOCK
    buf = jnp.zeros((rows, d), h.dtype).at[dest].set(h[tok_sorted])
    block_start = jnp.arange(n_blocks, dtype=jnp.int32) * MOE_BLOCK
    block_expert = jnp.minimum(jnp.searchsorted(pad_ends, block_start, side='right'), N_EXPERTS - 1)

    def run_block(args):
        xb, eid = args
        return expert_ffn(xb, w_up[eid], b_up[eid], w_down[eid], b_down[eid])

    y_buf = lax.map(run_block, (buf.reshape(n_blocks, MOE_BLOCK, d), block_expert)).reshape(rows, d)
    y = y_buf[dest] * w_sorted[:, None]
    return jax.ops.segment_sum(y, tok_sorted, num_segments=n_tok)


def setup_inputs(seed: int = 0) -> dict:
    key = jax.random.key(seed)
    ks = iter(jax.random.split(key, 40))

    def nrm(shape, scale):
        return jax.random.normal(next(ks), shape, F32) * scale

    D = D_MODEL
    H2 = 2 * D_EXPERT
    x = nrm((BATCH, SEQ, D), 1.0)
    c = nrm((BATCH, D), 1.0)
    ctx = nrm((BATCH, CTX_LEN, D), 1.0)
    c_ctx = nrm((D,), 1.0)
    ln_in_g = 1.0 + nrm((D,), 0.02)
    ln_in_b = nrm((D,), 0.02)
    w_ada = nrm((DEPTH, D, 6 * D), 0.5 * D ** -0.5)
    b_ada = nrm((DEPTH, 6 * D), 0.02)
    w_in = nrm((DEPTH, D, IN_WIDTH), D ** -0.5)
    b_in = nrm((DEPTH, IN_WIDTH), 0.02)
    s5_lambda_re = -0.5 + nrm((DEPTH, 2, S5_GROUPS, S5_STATE), 0.01)
    s5_lambda_im = jnp.pi * jnp.arange(S5_STATE, dtype=F32) + nrm((DEPTH, 2, S5_GROUPS, S5_STATE), 0.01)
    s5_log_dt = jax.random.uniform(next(ks), (DEPTH, 2, S5_GROUPS), F32,
                                   minval=math.log(DT_MIN), maxval=math.log(DT_MAX))
    s5_b_re = nrm((DEPTH, 2, S5_GROUPS, S5_STATE, S5_GROUP), (2 * S5_GROUP) ** -0.5)
    s5_b_im = nrm((DEPTH, 2, S5_GROUPS, S5_STATE, S5_GROUP), (2 * S5_GROUP) ** -0.5)
    s5_c_re = nrm((DEPTH, 2, S5_GROUPS, S5_GROUP, S5_STATE), (2 * S5_STATE) ** -0.5)
    s5_c_im = nrm((DEPTH, 2, S5_GROUPS, S5_GROUP, S5_STATE), (2 * S5_STATE) ** -0.5)
    s5_d = nrm((DEPTH, S5_WIDTH), 1.0)
    w_glu = nrm((DEPTH, S5_WIDTH, 2 * S5_WIDTH), S5_WIDTH ** -0.5)
    b_glu = nrm((DEPTH, 2 * S5_WIDTH), 0.02)
    w_br_s5 = nrm((DEPTH, S5_WIDTH, D), S5_WIDTH ** -0.5)
    w_br_fft = nrm((DEPTH, FFT_WIDTH, D), FFT_WIDTH ** -0.5)
    b_br_fft = nrm((DEPTH, D), 0.02)
    w_out = nrm((DEPTH, D, D), DEEPNORM_BETA * D ** -0.5)
    b_out = nrm((DEPTH, D), 0.02)
    ln1_g = 1.0 + nrm((DEPTH, D), 0.02)
    ln1_b = nrm((DEPTH, D), 0.02)
    w_router = nrm((DEPTH, D, N_EXPERTS), D ** -0.5)
    b_router = nrm((DEPTH, N_EXPERTS), 0.01)
    w_up = nrm((DEPTH, N_EXPERTS, D, H2), D ** -0.5)
    b_up = nrm((DEPTH, N_EXPERTS, H2), 0.02)
    w_down = nrm((DEPTH, N_EXPERTS, D_EXPERT, D), DEEPNORM_BETA * D_EXPERT ** -0.5)
    b_down = nrm((DEPTH, N_EXPERTS, D), 0.02)
    ln2_g = 1.0 + nrm((DEPTH, D), 0.02)
    ln2_b = nrm((DEPTH, D), 0.02)
    return {"x": x, "c": c, "ctx": ctx, "c_ctx": c_ctx, "ln_in_g": ln_in_g, "ln_in_b": ln_in_b,
            "w_ada": w_ada, "b_ada": b_ada, "w_in": w_in, "b_in": b_in,
            "s5_lambda_re": s5_lambda_re, "s5_lambda_im": s5_lambda_im, "s5_log_dt": s5_log_dt,
            "s5_b_re": s5_b_re, "s5_b_im": s5_b_im, "s5_c_re": s5_c_re, "s5_c_im": s5_c_im, "s5_d": s5_d,
            "w_glu": w_glu, "b_glu": b_glu, "w_br_s5": w_br_s5, "w_br_fft": w_br_fft, "b_br_fft": b_br_fft,
            "w_out": w_out, "b_out": b_out, "ln1_g": ln1_g, "ln1_b": ln1_b,
            "w_router": w_router, "b_router": b_router, "w_up": w_up, "b_up": b_up,
            "w_down": w_down, "b_down": b_down, "ln2_g": ln2_g, "ln2_b": ln2_b}


def reference(x, c, ctx, c_ctx, ln_in_g, ln_in_b, w_ada, b_ada, w_in, b_in,
              s5_lambda_re, s5_lambda_im, s5_log_dt, s5_b_re, s5_b_im, s5_c_re, s5_c_im, s5_d,
              w_glu, b_glu, w_br_s5, w_br_fft, b_br_fft, w_out, b_out, ln1_g, ln1_b,
              w_router, b_router, w_up, b_up, w_down, b_down, ln2_g, ln2_b):
    bsz, n_lat, d = x.shape
    n_ctx = ctx.shape[1]
    h = layer_norm(x + sincos_2d(n_lat, x.dtype)[None], ln_in_g, ln_in_b)
    hc = layer_norm(ctx, ln_in_g, ln_in_b)
    silu_c = jax.nn.silu(c)[:, None, :]
    silu_cc = jnp.broadcast_to(jax.nn.silu(c_ctx), (bsz, 1, d))
    split_cols = [S5_WIDTH, S5_WIDTH + FFT_WIDTH]
    zero_state = jnp.zeros((bsz, S5_GROUPS, S5_STATE), F32)
    for l in range(DEPTH):
        last = l == DEPTH - 1
        sh1, sc1, g1, sh2, sc2, g2 = jnp.split(silu_c @ w_ada[l] + b_ada[l], 6, axis=-1)
        sh1c, sc1c, g1c, sh2c, sc2c, g2c = jnp.split(silu_cc @ w_ada[l] + b_ada[l], 6, axis=-1)
        a_re, a_im, bb_re, bb_im = s5_discretise(s5_lambda_re[l], s5_lambda_im[l], s5_log_dt[l],
                                                 s5_b_re[l], s5_b_im[l])
        pc = modulate(hc, sh1c, sc1c) @ w_in[l] + b_in[l]
        pc_s5, pc_fft, pc_g = jnp.split(pc, split_cols, axis=-1)
        st_c = s5_states(pc_s5, ((zero_state, zero_state), (zero_state, zero_state)), a_re, a_im, bb_re, bb_im)
        s0 = ((st_c[0][0][:, -1], st_c[0][1][:, -1]), (st_c[1][0][:, 0], st_c[1][1][:, 0]))
        p = modulate(h, sh1, sc1) @ w_in[l] + b_in[l]
        p_s5, p_fft, p_g = jnp.split(p, split_cols, axis=-1)
        st = s5_states(p_s5, s0, a_re, a_im, bb_re, bb_im)
        y_s5 = s5_branch(s5_readout(st, p_s5, s5_c_re[l], s5_c_im[l], s5_d[l]), w_glu[l], b_glu[l], w_br_s5[l])
        y_fft = fourier_branch(p_fft, w_br_fft[l], b_br_fft[l])
        y = merge_branches(y_s5, y_fft, p_g, w_out[l], b_out[l])
        h = layer_norm(DEEPNORM_ALPHA * h + g1 * y, ln1_g[l], ln1_b[l])
        moe_args = (w_router[l], b_router[l], w_up[l], b_up[l], w_down[l], b_down[l])
        if last:
            m_lat = moe(modulate(h, sh2, sc2).reshape(-1, d), *moe_args).reshape(bsz, n_lat, d)
            h = layer_norm(DEEPNORM_ALPHA * h + g2 * m_lat, ln2_g[l], ln2_b[l])
        else:
            yc_s5 = s5_branch(s5_readout(st_c, pc_s5, s5_c_re[l], s5_c_im[l], s5_d[l]),
                              w_glu[l], b_glu[l], w_br_s5[l])
            yc_fft = fourier_branch(pc_fft, w_br_fft[l], b_br_fft[l])
            yc = merge_branches(yc_s5, yc_fft, pc_g, w_out[l], b_out[l])
            hc = layer_norm(DEEPNORM_ALPHA * hc + g1c * yc, ln1_g[l], ln1_b[l])
            u2 = jnp.concatenate([modulate(h, sh2, sc2).reshape(-1, d),
                                  modulate(hc, sh2c, sc2c).reshape(-1, d)], axis=0)
            m_all = moe(u2, *moe_args)
            m_lat = m_all[:bsz * n_lat].reshape(bsz, n_lat, d)
            m_ctx = m_all[bsz * n_lat:].reshape(bsz, n_ctx, d)
            h = layer_norm(DEEPNORM_ALPHA * h + g2 * m_lat, ln2_g[l], ln2_b[l])
            hc = layer_norm(DEEPNORM_ALPHA * hc + g2c * m_ctx, ln2_g[l], ln2_b[l])
    return h
```

```cpp
#include <hip/hip_runtime.h>
#include <cstdio>
#include <cstdint>

#define GAS __attribute__((address_space(1)))
#define LAS __attribute__((address_space(3)))
typedef unsigned short bf16;
typedef unsigned v4u __attribute__((ext_vector_type(4)));
typedef unsigned v2u __attribute__((ext_vector_type(2)));
typedef float f32x4 __attribute__((ext_vector_type(4)));
typedef float f32x2 __attribute__((ext_vector_type(2)));
typedef short bf16x8 __attribute__((ext_vector_type(8)));

namespace pg8 {
#define PG8_LAS __attribute__((address_space(3)))
constexpr int BM = 256, BK = 64, HALF = 128, HTB = HALF * BK * 2, STAGE_BYTES = 8 * HTB, NXCD = 8, WGM = 8;
__host__ __device__ __forceinline__ int lds_byte(int r, int c) { const int st = (r >> 4) * 2 + (c >> 5), rr = r & 15, cc = c & 31, ob = rr * 64 + cc * 2; return st * 1024 + (ob ^ (((ob >> 9) & 1) << 5)); }
__host__ __device__ __forceinline__ void stage_rc(int b, int& R, int& C) { const int st = b / 1024, sb = b % 1024, swz = sb ^ (((sb >> 9) & 1) << 5); R = (st >> 1) * 16 + swz / 64; C = (st & 1) * 32 + (swz % 64) / 2; }
__host__ __device__ __forceinline__ int perm32(int rho) { const int n = rho >> 4, i = rho & 15; return 8 * (i >> 2) + 4 * n + (i & 3); }

struct Unit { int pa, pb, pm, pn, aux; };
struct Gemm { const bf16* A; const bf16* Bt; int K, lda, ldb; };

struct StaticOrder {
    int nM, nN, nwg, G, c;
    __device__ void init(int M, int N, int G_, int c_) { nM = M / BM; nN = N / BM; nwg = nM * nN; G = G_; c = c_; }
    __device__ bool next(int i, Unit& u) const {
        const long L = (long)i * G + c; if (L >= nwg) return false;
        int wgid = (int)L; { const int q = nwg / NXCD, r = nwg % NXCD, xcd = wgid % NXCD, off = wgid / NXCD; wgid = (xcd < r ? xcd * (q + 1) : r * (q + 1) + (xcd - r) * q) + off; }
        const int nig = WGM * nN, gid = wgid / nig, fm = gid * WGM, gsz = (nM - fm) < WGM ? (nM - fm) : WGM;
        u.pm = fm + ((wgid % nig) % gsz); u.pn = (wgid % nig) / gsz; u.pa = u.pm; u.pb = u.pn; u.aux = 0; return true;
    }
};
struct GroupOrder {
    int nG, nMg, nNg, G, c, shareB;
    __device__ void init(int nG_, int nMg_, int nNg_, int G_, int c_, int off) { nG = nG_; nMg = nMg_; nNg = nNg_; G = G_; c = (c_ - off % G_ + G_) % G_; }
    __device__ bool next(int i, Unit& u) const {
        const long L = (long)i * G + c; if (L >= (long)nG * nMg * nNg) return false;
        const int per = nMg * nNg, g = (int)L / per, r = (int)L % per;
        u.pm = r / nNg; u.pn = r % nNg; u.aux = g; u.pa = g * nMg + u.pm; u.pb = shareB ? u.pn : g * nNg + u.pn; return true;
    }
};
template <int NPN> struct MoeOrder {
    const int* texp; int ntiles, G, c;
    __device__ bool next(int i, Unit& u) const {
        const long L = (long)i * G + c; if (L >= (long)ntiles * NPN) return false;
        const int tr = (int)(L / NPN), pn = (int)(L % NPN), e = texp[tr];
        u.pm = tr; u.pn = pn; u.aux = e; u.pa = tr; u.pb = e * NPN + pn; return true;
    }
};

template <class S> struct OneUnit { const S& s; int which; __device__ __forceinline__ bool next(int i, Unit& u) const { return i == 0 ? s.next(which, u) : false; } };

typedef __bf16 bf16x2_t __attribute__((ext_vector_type(2)));
__device__ __forceinline__ unsigned cvt_pk_bf16(float lo, float hi) { const f32x2 v = {lo, hi}; const bf16x2_t r = __builtin_convertvector(v, bf16x2_t); return __builtin_bit_cast(unsigned, r); }

template <class Epi, class Sched, bool ALIGN_EPI>
__device__ __forceinline__ void gemm_phase(PG8_LAS unsigned char* lds, const Gemm g, const Sched& S, const Epi& E, const int tid) {
    const int wid = __builtin_amdgcn_readfirstlane(tid >> 6), lane = tid & 63, wr = wid >> 2, wc = wid & 3, fr = lane & 15, fq = lane >> 4;
    int Kop = g.K; asm volatile("" : "+s"(Kop));
    const int nt = Kop / BK;
    unsigned voffA[2], voffB[2];
#pragma unroll
    for (int i = 0; i < 2; ++i) { int R, C; stage_rc(tid * 16 + i * 8192, R, C); const int Rb = Epi::PERM ? ((R & ~31) + perm32(R & 31)) : R;
        voffA[i] = (unsigned)(R * g.lda + C) * 2u; voffB[i] = (unsigned)(Rb * g.ldb + C) * 2u; }
    const size_t kstep = (size_t)(BK * 2);
    const size_t hstepA = (size_t)HALF * g.lda * 2, hstepB = (size_t)HALF * g.ldb * 2;
    const size_t tstepA = 2 * hstepA, tstepB = 2 * hstepB;
    const unsigned ldsw = (unsigned)wid * 1024u;
    const int aoff = lds_byte(wr * 64 + fr, fq * 8), boff = lds_byte(wc * 32 + fr, fq * 8);
#define PG8_SA(b, h) (((b) * 2 + (h)) * HTB)
#define PG8_SB(b, h) ((4 + (b) * 2 + (h)) * HTB)
#define PG8_STAGE(bufoff, gbase, voff) do { _Pragma("unroll") for (int _i = 0; _i < 2; ++_i) \
        __builtin_amdgcn_global_load_lds((const unsigned*)((const char*)(gbase) + (voff)[_i]), (PG8_LAS unsigned*)(lds + (bufoff) + ldsw + _i * 8192), 16, 0, 0); } while (0)
#define PG8_LDA(dst, b, h) do { _Pragma("unroll") for (int m = 0; m < 4; ++m) _Pragma("unroll") for (int k = 0; k < 2; ++k) dst[m][k] = *(const PG8_LAS bf16x8*)(lds + PG8_SA(b, h) + aoff + m * 2048 + k * 1024); } while (0)
#define PG8_LDB(dst, b, h) do { _Pragma("unroll") for (int n = 0; n < 2; ++n) _Pragma("unroll") for (int k = 0; k < 2; ++k) dst[n][k] = *(const PG8_LAS bf16x8*)(lds + PG8_SB(b, h) + boff + n * 2048 + k * 1024); } while (0)
#define PG8_MMA(ai, bj, At, Bt) do { __builtin_amdgcn_s_setprio(1); _Pragma("unroll") for (int m = 0; m < 4; ++m) _Pragma("unroll") for (int n = 0; n < 2; ++n) _Pragma("unroll") for (int k = 0; k < 2; ++k) \
        acc[ai][bj][m][n] = __builtin_amdgcn_mfma_f32_16x16x32_bf16(Bt[n][k], At[m][k], acc[ai][bj][m][n], 0, 0, 0); __builtin_amdgcn_s_setprio(0); } while (0)
#define PG8_WAIT_V(n) asm volatile("s_waitcnt vmcnt(" #n ")" ::: "memory")
#define PG8_WAIT_L(n) asm volatile("s_waitcnt lgkmcnt(" #n ")" ::: "memory")
#define PG8_BAR __builtin_amdgcn_s_barrier()
#define PG8_SCHED __builtin_amdgcn_sched_barrier(0)
    Unit cur, nxt; int ui = 0;
    if (!S.next(0, cur)) return;
    f32x4 acc[2][2][4][2];
#pragma unroll
    for (int a = 0; a < 2; ++a)
#pragma unroll
        for (int b = 0; b < 2; ++b)
#pragma unroll
            for (int m = 0; m < 4; ++m)
#pragma unroll
                for (int n = 0; n < 2; ++n) acc[a][b][m][n] = (f32x4){0.f, 0.f, 0.f, 0.f};
    bf16x8 At[4][2], B0[2][2], B1[2][2];
    const char* cA = (const char*)g.A + (size_t)cur.pa * tstepA; const char* cB = (const char*)g.Bt + (size_t)cur.pb * tstepB;
    PG8_STAGE(PG8_SB(0, 0), cB, voffB); PG8_STAGE(PG8_SB(0, 1), cB + hstepB, voffB); PG8_STAGE(PG8_SA(0, 0), cA, voffA); PG8_STAGE(PG8_SA(0, 1), cA + hstepA, voffA);
    if (wr == 1) PG8_BAR;
    PG8_WAIT_V(2); PG8_BAR;
    PG8_STAGE(PG8_SB(1, 0), cB + kstep, voffB); PG8_STAGE(PG8_SA(1, 0), cA + kstep, voffA); PG8_STAGE(PG8_SB(1, 1), cB + hstepB + kstep, voffB);
    PG8_WAIT_V(6); PG8_BAR;
    for (;;) {
        const bool has_next = S.next(ui + 1, nxt);
        const char* nA = has_next ? (const char*)g.A + (size_t)nxt.pa * tstepA : cA; const char* nB = has_next ? (const char*)g.Bt + (size_t)nxt.pb * tstepB : cB;
        for (int t = 0; t < nt; t += 2) {
            const bool last = (t == nt - 2);
            const char* a1 = cA + (size_t)(t + 1) * kstep;
            const char* a2 = last ? nA : cA + (size_t)(t + 2) * kstep; const char* b2 = last ? nB : cB + (size_t)(t + 2) * kstep;
            const char* a3 = a2 + kstep; const char* b3 = b2 + kstep;
            PG8_LDB(B0, 0, 0); PG8_LDB(B1, 0, 1); PG8_SCHED; PG8_LDA(At, 0, 0); PG8_STAGE(PG8_SA(1, 1), a1 + hstepA, voffA);
            PG8_WAIT_V(8); PG8_WAIT_L(0); PG8_BAR; PG8_MMA(0, 0, At, B0); PG8_MMA(0, 1, At, B1); PG8_BAR; PG8_SCHED;
            PG8_LDA(At, 0, 1); PG8_STAGE(PG8_SB(0, 0), b2, voffB); PG8_STAGE(PG8_SB(0, 1), b2 + hstepB, voffB); PG8_STAGE(PG8_SA(0, 0), a2, voffA);
            PG8_WAIT_V(8); PG8_WAIT_L(0); PG8_BAR; PG8_MMA(1, 0, At, B0); PG8_MMA(1, 1, At, B1); PG8_BAR; PG8_SCHED;
            PG8_LDB(B0, 1, 0); PG8_LDB(B1, 1, 1); PG8_SCHED; PG8_LDA(At, 1, 0); PG8_STAGE(PG8_SA(0, 1), a2 + hstepA, voffA);
            PG8_WAIT_V(8); PG8_WAIT_L(0); PG8_BAR; PG8_MMA(0, 0, At, B0); PG8_MMA(0, 1, At, B1); PG8_BAR; PG8_SCHED;
            PG8_LDA(At, 1, 1); PG8_STAGE(PG8_SB(1, 0), b3, voffB); PG8_STAGE(PG8_SB(1, 1), b3 + hstepB, voffB); PG8_STAGE(PG8_SA(1, 0), a3, voffA);
            PG8_WAIT_V(8); PG8_WAIT_L(0); PG8_BAR; PG8_MMA(1, 0, At, B0); PG8_MMA(1, 1, At, B1); PG8_BAR; PG8_SCHED;
        }
        if constexpr (ALIGN_EPI) { if (wr == 0) PG8_BAR; }
        E(acc, cur, wr, wc, fr, fq);
        if (!has_next) break;
#pragma unroll
        for (int a = 0; a < 2; ++a)
#pragma unroll
            for (int b = 0; b < 2; ++b)
#pragma unroll
                for (int m = 0; m < 4; ++m)
#pragma unroll
                    for (int n = 0; n < 2; ++n) acc[a][b][m][n] = (f32x4){0.f, 0.f, 0.f, 0.f};
        cur = nxt; cA = nA; cB = nB; ++ui;
        if constexpr (ALIGN_EPI) { if (wr == 1) PG8_BAR; }
    }
    PG8_WAIT_V(0);
    if constexpr (!ALIGN_EPI) { if (wr == 0) PG8_BAR; }
    PG8_BAR;
#undef PG8_SA
#undef PG8_SB
#undef PG8_STAGE
#undef PG8_LDA
#undef PG8_LDB
#undef PG8_MMA
#undef PG8_WAIT_V
#undef PG8_WAIT_L
#undef PG8_BAR
#undef PG8_SCHED
}
}

#ifndef PHMASK
#define PHMASK 0xffffffffu
#endif
constexpr int SEQ = 16384, DM = 1024, CTXL = 256, NG = 32, GH = 16, NP = 64, TC = 32, NCH = SEQ / TC, NCC = CTXL / TC;
constexpr int NEXP = 32, TOPK = 4, DEXP = 1024;
constexpr float LN_EPS = 1e-5f;
constexpr float DN_ALPHA = 1.189207115002721f;
constexpr int NWAVES = 8;
constexpr int LDS_BYTES = 147456, RING_BYTES = 131072, LDSCTL_OFF = RING_BYTES, MISC_OFF = LDSCTL_OFF + 320;
constexpr int MAXTILES = 288;

constexpr size_t MiB = 1u << 20;
constexpr size_t WS_CTL = 0, CTL_ZERO_BYTES = 1 * MiB;
constexpr int CW_BAR = 4096;
constexpr size_t WS_MODP = 1 * MiB;
constexpr size_t WS_MOD  = 2 * MiB;
constexpr size_t WS_POS  = 2 * MiB + 64 * 1024;
constexpr size_t WS_TW   = 3 * MiB;
constexpr size_t WS_PCS  = 3 * MiB + 256 * 1024;
constexpr size_t WS_ECTX = 4 * MiB;
constexpr size_t WS_ZP   = 4 * MiB + 512 * 1024;
constexpr size_t WS_BIASP1 = 5 * MiB + 512 * 1024;
constexpr size_t WS_WRI  = 6 * MiB;
constexpr size_t WS_EID  = 7 * MiB;
constexpr size_t WS_GATE = 7 * MiB + 256 * 1024;
constexpr size_t WS_HIST = 7 * MiB + 512 * 1024;
constexpr size_t WS_SROW = 8 * MiB;
constexpr size_t WS_SGATE = 8 * MiB + 512 * 1024;
constexpr size_t WS_TEXP = 9 * MiB;
constexpr size_t WS_AB   = 10 * MiB;
constexpr size_t WS_BB   = 12 * MiB;
constexpr size_t WS_KT   = 14 * MiB;
constexpr size_t WS_WGLU = 20 * MiB, WS_WBRS = 21 * MiB, WS_WBRF = 22 * MiB, WS_WOUT = 23 * MiB, WS_WDFT = 25 * MiB;
constexpr size_t WS_WUP  = 32 * MiB;
constexpr size_t WS_WDN  = 160 * MiB;
constexpr size_t WS_RES  = 224 * MiB;
constexpr size_t WS_UB   = 288 * MiB;
constexpr size_t WS_WIN  = 320 * MiB;
constexpr size_t WS_MYT  = 326 * MiB;
constexpr size_t WS_MET  = 350 * MiB;
constexpr size_t WS_ACAT = 358 * MiB;
constexpr size_t WS_A1   = 382 * MiB, WS_A2 = 398 * MiB;
constexpr size_t WS_E    = 414 * MiB;
constexpr size_t WS_GT   = 430 * MiB;
constexpr size_t WS_Y5   = 494 * MiB, WS_ZR = 510 * MiB, WS_Z5 = 526 * MiB;
constexpr size_t WS_V1   = 542 * MiB;
constexpr size_t WS_V    = 606 * MiB;
constexpr size_t WS_XS   = 320 * MiB;
constexpr size_t WS_ACT  = 464 * MiB;
constexpr size_t WS_Y2   = 608 * MiB;
constexpr size_t WS_END  = 736 * MiB;

#define LDS_WAIT() asm volatile("s_waitcnt lgkmcnt(0)" ::: "memory")
#define VM_WAIT() asm volatile("s_waitcnt vmcnt(0)" ::: "memory")
__device__ __forceinline__ unsigned f2bf(float f) { unsigned u = __builtin_bit_cast(unsigned, f); return (u + 0x7fffu + ((u >> 16) & 1u)) >> 16; }
__device__ __forceinline__ unsigned pk2(float lo, float hi) { return f2bf(lo) | (f2bf(hi) << 16); }
__device__ __forceinline__ float bf2f(unsigned h) { return __builtin_bit_cast(float, h << 16); }
__device__ __forceinline__ float wave_sum(float v) {
#pragma unroll
    for (int o = 1; o < 64; o <<= 1) v += __shfl_xor(v, o);
    return v;
}
__device__ __forceinline__ float sigmoidf_(float y) { return __builtin_amdgcn_rcpf(1.0f + __builtin_amdgcn_exp2f(-1.4426950408889634f * y)); }
__device__ __forceinline__ float gelu_tanh(float x) { const float z = 0.7978845608028654f * (x + 0.044715f * x * x * x); return x * sigmoidf_(2.0f * z); }
__device__ __forceinline__ int row_of_tok(int t) { return ((t & 127) << 7) | (t >> 7); }

#define XB_TMO      128
#define XB_XCNT(j)  (256  + 64 * (j))
#define XB_XSUB(j)  (1280 + 64 * (j))
#define XB_XGEN(j)  (2304 + 64 * (j))
#define XB_TOP      3328
#define XB_TOPGEN   3392
#define XCD_BAR_WORDS 3456
#define XB_SPIN_CAP (1u << 18)
__device__ __forceinline__ unsigned xb_ld(unsigned* p)              { return __hip_atomic_load(p, __ATOMIC_RELAXED, __HIP_MEMORY_SCOPE_AGENT); }
__device__ __forceinline__ unsigned xb_add(unsigned* p, unsigned v) { return __hip_atomic_fetch_add(p, v, __ATOMIC_RELAXED, __HIP_MEMORY_SCOPE_AGENT); }
__device__ __forceinline__ unsigned xb_xcc_id() { return (unsigned)__builtin_amdgcn_s_getreg((3 << 11) | 20) & 0xFu; }
#define XB_SPIN(cond, bar) do { unsigned _sp = 0; while (cond) { __builtin_amdgcn_s_sleep(1); \
    if ((++_sp & 255u) == 0u) { if (xb_ld(&(bar)[XB_TMO])) break; if (_sp > XB_SPIN_CAP) { atomicAdd(&(bar)[XB_TMO], 1u); break; } } } } while (0)
struct XcdBarrier { unsigned* bar; unsigned x; volatile LAS unsigned* st; };
__device__ __forceinline__ XcdBarrier xcd_barrier_post(unsigned* bar, volatile LAS unsigned* st) {
    XcdBarrier b; b.bar = bar; b.x = xb_xcc_id(); b.st = st;
    if (threadIdx.x == 0) (void)xb_add(&bar[XB_XCNT(b.x)], 1u);
    return b;
}
__device__ __forceinline__ void xcd_barrier_complete(unsigned* bar, unsigned x, unsigned& nloc, unsigned& nx) {
    const unsigned G = gridDim.x * gridDim.y * gridDim.z;
    unsigned sum, cnt, mine, sp = 0u;
    for (;;) {
        sum = 0u; cnt = 0u; mine = 0u;
#pragma unroll
        for (unsigned j = 0; j < 16; ++j) { const unsigned c = xb_ld(&bar[XB_XCNT(j)]); sum += c; cnt += (c > 0u) ? 1u : 0u; mine = (j == x) ? c : mine; }
        if (sum == G) break;
        __builtin_amdgcn_s_sleep(1);
        if ((++sp & 255u) == 0u) { if (xb_ld(&bar[XB_TMO])) break; if (sp > XB_SPIN_CAP) { atomicAdd(&bar[XB_TMO], 1u); break; } }
    }
    nloc = mine > 0u ? mine : 1u; nx = cnt > 0u ? cnt : 1u;
}
__device__ __forceinline__ void xcd_barrier(const XcdBarrier& b) {
    asm volatile("s_waitcnt vmcnt(0)" ::: "memory");
    __syncthreads();
    if (threadIdx.x == 0) {
        unsigned* bar = b.bar;
        __builtin_amdgcn_s_waitcnt(0);
        unsigned nloc = b.st[0], nx = b.st[1];
        if (nloc == 0u) { xcd_barrier_complete(bar, b.x, nloc, nx); b.st[0] = nloc; b.st[1] = nx; }
        const unsigned old = xb_add(&bar[XB_XSUB(b.x)], 1u);
        const unsigned gen = old / nloc;
        if (old + 1u == (gen + 1u) * nloc) {
            __builtin_amdgcn_fence(__ATOMIC_RELEASE, "agent");
            asm volatile("s_waitcnt vmcnt(0)" ::: "memory");
            const unsigned og = xb_add(&bar[XB_TOP], 1u);
            const unsigned tg = og / nx;
            if (og + 1u == (tg + 1u) * nx) xb_add(&bar[XB_TOPGEN], 1u);
            else XB_SPIN(xb_ld(&bar[XB_TOPGEN]) == tg, bar);
            __builtin_amdgcn_fence(__ATOMIC_ACQUIRE, "agent");
            xb_add(&bar[XB_XGEN(b.x)], 1u);
            asm volatile("s_waitcnt vmcnt(0)" ::: "memory");
        } else {
            XB_SPIN(xb_ld(&bar[XB_XGEN(b.x)]) == gen, bar);
            __builtin_amdgcn_fence(__ATOMIC_ACQUIRE, "agent");
            asm volatile("s_waitcnt vmcnt(0)" ::: "memory");
        }
    }
    __syncthreads();
}

enum { I_X = 0, I_C, I_CTX, I_CCTX, I_LNING, I_LNINB, I_WADA, I_BADA, I_WIN, I_BIN, I_LAMRE, I_LAMIM, I_LOGDT, I_BRE, I_BIM, I_CRE, I_CIM, I_S5D,
       I_WGLU, I_BGLU, I_WBRS, I_WBRF, I_BBRF, I_WOUT, I_BOUT, I_LN1G, I_LN1B, I_WR, I_BR, I_WUP, I_BUP, I_WDN, I_BDN, I_LN2G, I_LN2B, N_IN };
struct Args { const float* in[N_IN]; float* out; unsigned char* ws; };

__device__ __forceinline__ void transpose_item(const float* W, int K, int N, bf16* WT, int k0, int n0, int drow0, LAS float* scr, int lane) {
#pragma unroll 8
    for (int i = 0; i < 32; ++i) { const int kk = 2 * i + (lane >> 5); scr[kk * 33 + (lane & 31)] = W[(size_t)(k0 + kk) * N + n0 + (lane & 31)]; }
    LDS_WAIT(); asm volatile("" ::: "memory");
    const int c = lane & 7;
#pragma unroll
    for (int j = 0; j < 4; ++j) { const int n = (lane >> 3) + 8 * j; const LAS float* s = scr + (8 * c) * 33 + n;
        v4u o; o.x = pk2(s[0 * 33], s[1 * 33]); o.y = pk2(s[2 * 33], s[3 * 33]); o.z = pk2(s[4 * 33], s[5 * 33]); o.w = pk2(s[6 * 33], s[7 * 33]);
        *(GAS v4u*)(WT + (size_t)(drow0 + n) * K + k0 + 8 * c) = o; }
    LDS_WAIT(); asm volatile("" ::: "memory");
}
__device__ __forceinline__ int paired_row(int n, int HN) { return n < HN ? ((n >> 7) << 8) + (n & 127) : (((n - HN) >> 7) << 8) + 128 + ((n - HN) & 127); }

using pg8::Unit; using pg8::cvt_pk_bf16;
#define EPI_ARGS const f32x4 (&acc)[2][2][4][2], const Unit& u, int wr, int wc, int fr, int fq

struct EpiP1 {
    static constexpr bool PERM = true;
    const float* bias; bf16* acat; bf16* a1; bf16* gt;
    __device__ __forceinline__ void operator()(EPI_ARGS) const {
        const int row0 = u.pm * 256 + wr * 64 + fr;
#pragma unroll
        for (int bj = 0; bj < 2; ++bj) {
            const int c0 = u.pn * 256 + bj * 128 + wc * 32 + 8 * fq;
            const f32x4 b0 = *(const f32x4*)(bias + c0), b1 = *(const f32x4*)(bias + c0 + 4);
#pragma unroll
            for (int ai = 0; ai < 2; ++ai)
#pragma unroll
                for (int m = 0; m < 4; ++m) {
                    const int r = row0 + ai * 128 + m * 16;
                    f32x4 v0 = acc[ai][bj][m][0] + b0, v1 = acc[ai][bj][m][1] + b1;
                    if (u.pn < 2) {
                        const int t = row_of_tok(r), ci = t >> 5, tau = t & 31, g = c0 >> 4, h0 = c0 & 15;
                        v4u w; w.x = cvt_pk_bf16(v0[0], v0[1]); w.y = cvt_pk_bf16(v0[2], v0[3]); w.z = cvt_pk_bf16(v1[0], v1[1]); w.w = cvt_pk_bf16(v1[2], v1[3]);
                        *(v4u*)(acat + ((size_t)(g * NCH + ci) * 768 + tau * 16 + h0)) = w;
                    } else if (u.pn < 4) {
                        const int cc = c0 - 512, g = cc >> 7, j0 = (cc & 127) >> 1, n2 = r >> 7, n1 = r & 127;
                        const unsigned w[4] = {cvt_pk_bf16(v0[0], v0[1]), cvt_pk_bf16(v0[2], v0[3]), cvt_pk_bf16(v1[0], v1[1]), cvt_pk_bf16(v1[2], v1[3])};
#pragma unroll
                        for (int q = 0; q < 4; ++q) { const int colc = g * 64 + j0 + q, rho1 = (colc >> 1) * 256 + (colc & 1) * 128 + n2;
                            *(unsigned*)(a1 + ((size_t)rho1 * 256 + 2 * n1)) = w[q]; }
                    } else {
                        v4u w; w.x = cvt_pk_bf16(sigmoidf_(v0[0]), sigmoidf_(v0[1])); w.y = cvt_pk_bf16(sigmoidf_(v0[2]), sigmoidf_(v0[3]));
                        w.z = cvt_pk_bf16(sigmoidf_(v1[0]), sigmoidf_(v1[1])); w.w = cvt_pk_bf16(sigmoidf_(v1[2]), sigmoidf_(v1[3]));
#ifdef DBG_CONSTGT
                        w = (v4u){0x3f803f80u, 0x3f803f80u, 0x3f803f80u, 0x3f803f80u};
#endif
#ifdef DBG_RAWGT
                        w.x = cvt_pk_bf16(v0[0], v0[1]); w.y = cvt_pk_bf16(v0[2], v0[3]); w.z = cvt_pk_bf16(v1[0], v1[1]); w.w = cvt_pk_bf16(v1[2], v1[3]);
#endif
                        *(v4u*)(gt + ((size_t)r * 2048 + (c0 - 1024))) = w;
                    }
                }
        }
    }
};
struct EpiF1 {
    static constexpr bool PERM = true;
    const float* tw; bf16* a2;
    __device__ __forceinline__ void operator()(EPI_ARGS) const {
#pragma unroll
        for (int ai = 0; ai < 2; ++ai)
#pragma unroll
            for (int m = 0; m < 4; ++m) {
                const unsigned rho1 = u.pa * 256 + ai * 128 + wr * 64 + m * 16 + fr, colc = rho1 >> 7, n2 = rho1 & 127;
#pragma unroll
                for (int bj = 0; bj < 2; ++bj) {
                    const unsigned m10 = (bj * 128 + wc * 32 + 8 * fq) >> 1;
                    const f32x4 t0 = *(const f32x4*)(tw + (n2 * 128u + m10) * 2u), t1 = *(const f32x4*)(tw + (n2 * 128u + m10 + 2u) * 2u);
                    const f32x4 v0 = acc[ai][bj][m][0], v1 = acc[ai][bj][m][1];
                    const unsigned o0 = (m10 * 256u + colc) * 256u + 2u * n2;
                    *(unsigned*)(a2 + o0)             = cvt_pk_bf16(v0[0] * t0[0] - v0[1] * t0[1], v0[0] * t0[1] + v0[1] * t0[0]);
                    *(unsigned*)(a2 + o0 + 65536u)    = cvt_pk_bf16(v0[2] * t0[2] - v0[3] * t0[3], v0[2] * t0[3] + v0[3] * t0[2]);
                    *(unsigned*)(a2 + o0 + 2u * 65536u) = cvt_pk_bf16(v1[0] * t1[0] - v1[1] * t1[1], v1[0] * t1[1] + v1[1] * t1[0]);
                    *(unsigned*)(a2 + o0 + 3u * 65536u) = cvt_pk_bf16(v1[2] * t1[2] - v1[3] * t1[3], v1[2] * t1[3] + v1[3] * t1[2]);
                }
                asm volatile("" ::: "memory");
            }
    }
};
struct EpiF2 {
    static constexpr bool PERM = true;
    bf16* zr; float* zp;
    __device__ __forceinline__ void operator()(EPI_ARGS) const {
        const unsigned m1 = u.pa, m1p = m1 > 0 ? 128 - m1 : 0;
#pragma unroll
        for (int ai = 0; ai < 2; ++ai)
#pragma unroll
            for (int m = 0; m < 4; ++m) {
                const unsigned colc = ai * 128 + wr * 64 + m * 16 + fr, g = colc >> 6, j = colc & 63;
#pragma unroll
                for (int bj = 0; bj < 2; ++bj) {
                    const unsigned m20 = bj * 64 + wc * 16 + 4 * fq;
                    const f32x4 v0 = acc[ai][bj][m][0], v1 = acc[ai][bj][m][1];
                    const float re[4] = {v0[0], v0[2], v1[0], v1[2]}, im[4] = {v0[1], v0[3], v1[1], v1[3]};
                    const unsigned o0 = (m1 * 128u + m20) * 512u + g * 128u + j;
                    if (j >= 1) {
#pragma unroll
                        for (int q = 0; q < 4; ++q) { const unsigned m2 = m20 + q, m2p = m1 > 0 ? 127u - m2 : ((128u - m2) & 127u); const bf16 h = (bf16)f2bf(re[q]);
                            zr[o0 + q * 512u] = h; zr[(m1p * 128u + m2p) * 512u + g * 128u + 128u - j] = h; }
                    } else {
#pragma unroll
                        for (int q = 0; q < 4; ++q) *(f32x2*)(zp + ((m1 * 128u + m20 + q) * 4u + g) * 2u) = (f32x2){re[q], im[q]};
                    }
                }
                asm volatile("" ::: "memory");
            }
    }
};
struct EpiE {
    static constexpr bool PERM = false;
    float* e;
    __device__ __forceinline__ void operator()(EPI_ARGS) const {
#pragma unroll
        for (int ai = 0; ai < 2; ++ai)
#pragma unroll
            for (int m = 0; m < 4; ++m) { float* rowp = e + (size_t)(u.pa * 256 + ai * 128 + wr * 64 + m * 16 + fr) * 256 + wc * 32 + 4 * fq;
#pragma unroll
                for (int bj = 0; bj < 2; ++bj)
#pragma unroll
                    for (int n = 0; n < 2; ++n) *(f32x4*)(rowp + bj * 128 + n * 16) = acc[ai][bj][m][n]; }
    }
};
struct EpiY5 {
    static constexpr bool PERM = true;
    bf16* y5;
    __device__ __forceinline__ void operator()(EPI_ARGS) const {
        const int g = u.aux;
#pragma unroll
        for (int ai = 0; ai < 2; ++ai)
#pragma unroll
            for (int m = 0; m < 4; ++m) {
                const int c = u.pm * 256 + ai * 128 + wr * 64 + m * 16 + fr;
#pragma unroll
                for (int bj = 0; bj < 2; ++bj) {
                    const int n_ = u.pn * 256 + bj * 128 + wc * 32 + 8 * fq, tau = n_ >> 4, h0 = n_ & 15, r = row_of_tok(32 * c + tau);
                    const f32x4 v0 = acc[ai][bj][m][0], v1 = acc[ai][bj][m][1];
                    v4u w; w.x = cvt_pk_bf16(gelu_tanh(v0[0]), gelu_tanh(v0[1])); w.y = cvt_pk_bf16(gelu_tanh(v0[2]), gelu_tanh(v0[3]));
                    w.z = cvt_pk_bf16(gelu_tanh(v1[0]), gelu_tanh(v1[1])); w.w = cvt_pk_bf16(gelu_tanh(v1[2]), gelu_tanh(v1[3]));
                    *(v4u*)(y5 + ((size_t)r * 512 + g * 16 + h0)) = w;
                }
            }
    }
};
template <int MODE> struct EpiPair {
    static constexpr bool PERM = true;
    bf16* o; int ldo; const float* bias; int hn;
    __device__ __forceinline__ void operator()(EPI_ARGS) const {
        const float* bb = bias + (MODE == 1 ? (size_t)u.aux * 2 * hn : 0);
        const int cl = u.pn * 128 + wc * 32 + 8 * fq;
        const f32x4 ba0 = *(const f32x4*)(bb + cl), ba1 = *(const f32x4*)(bb + cl + 4), bb0 = *(const f32x4*)(bb + hn + cl), bb1 = *(const f32x4*)(bb + hn + cl + 4);
#pragma unroll
        for (int ai = 0; ai < 2; ++ai)
#pragma unroll
            for (int m = 0; m < 4; ++m) {
                const int r = u.pm * 256 + ai * 128 + wr * 64 + m * 16 + fr;
                const f32x4 a0 = acc[ai][0][m][0] + ba0, a1 = acc[ai][0][m][1] + ba1, g0 = acc[ai][1][m][0] + bb0, g1 = acc[ai][1][m][1] + bb1;
                float o8[8];
#pragma unroll
                for (int i = 0; i < 4; ++i) {
                    if (MODE == 0) { o8[i] = a0[i] * sigmoidf_(g0[i]); o8[4 + i] = a1[i] * sigmoidf_(g1[i]); }
                    else { const float x0 = fminf(a0[i], 7.0f), x1 = fminf(a1[i], 7.0f), l0 = fminf(fmaxf(g0[i], -7.0f), 7.0f), l1 = fminf(fmaxf(g1[i], -7.0f), 7.0f);
                        o8[i] = x0 * sigmoidf_(1.702f * x0) * (l0 + 1.0f); o8[4 + i] = x1 * sigmoidf_(1.702f * x1) * (l1 + 1.0f); }
                }
                v4u w; w.x = cvt_pk_bf16(o8[0], o8[1]); w.y = cvt_pk_bf16(o8[2], o8[3]); w.z = cvt_pk_bf16(o8[4], o8[5]); w.w = cvt_pk_bf16(o8[6], o8[7]);
                *(v4u*)(o + ((size_t)r * ldo + cl)) = w;
            }
    }
};
struct EpiV1 {
    static constexpr bool PERM = true;
    float* v1; const bf16* gt;
    __device__ __forceinline__ void operator()(EPI_ARGS) const {
#pragma unroll
        for (int ai = 0; ai < 2; ++ai)
#pragma unroll
            for (int m = 0; m < 4; ++m) {
                const int r = u.pm * 256 + ai * 128 + wr * 64 + m * 16 + fr;
#pragma unroll
                for (int bj = 0; bj < 2; ++bj) {
                    const int c0 = u.pn * 256 + bj * 128 + wc * 32 + 8 * fq;
                    const v4u gw = *(const v4u*)(gt + ((size_t)r * 2048 + c0));
                    const f32x4 v0 = acc[ai][bj][m][0], v1_ = acc[ai][bj][m][1];
                    f32x4 o0, o1;
                    o0[0] = v0[0] * bf2f(gw.x & 0xffffu); o0[1] = v0[1] * bf2f(gw.x >> 16); o0[2] = v0[2] * bf2f(gw.y & 0xffffu); o0[3] = v0[3] * bf2f(gw.y >> 16);
                    o1[0] = v1_[0] * bf2f(gw.z & 0xffffu); o1[1] = v1_[1] * bf2f(gw.z >> 16); o1[2] = v1_[2] * bf2f(gw.w & 0xffffu); o1[3] = v1_[3] * bf2f(gw.w >> 16);
                    float* p = v1 + ((size_t)r * 1024 + c0);
                    *(f32x4*)p = o0; *(f32x4*)(p + 4) = o1;
                }
            }
    }
};
struct EpiV {
    static constexpr bool PERM = true;
    const float* v1; const bf16* gt; const float* bias; bf16* v;
    __device__ __forceinline__ void operator()(EPI_ARGS) const {
#pragma unroll
        for (int bj = 0; bj < 2; ++bj) {
            const int c0 = u.pn * 256 + bj * 128 + wc * 32 + 8 * fq;
            const f32x4 b0 = *(const f32x4*)(bias + c0), b1 = *(const f32x4*)(bias + c0 + 4);
#pragma unroll
            for (int ai = 0; ai < 2; ++ai)
#pragma unroll
                for (int m = 0; m < 4; ++m) {
                    const int r = u.pm * 256 + ai * 128 + wr * 64 + m * 16 + fr;
                    const v4u gw = *(const v4u*)(gt + ((size_t)r * 2048 + 1024 + c0));
                    const float* p = v1 + ((size_t)r * 1024 + c0);
                    const f32x4 p0 = *(const f32x4*)p, p1 = *(const f32x4*)(p + 4);
                    const f32x4 v0 = acc[ai][bj][m][0] + b0, v1_ = acc[ai][bj][m][1] + b1;
                    float o[8];
                    o[0] = p0[0] + v0[0] * bf2f(gw.x & 0xffffu); o[1] = p0[1] + v0[1] * bf2f(gw.x >> 16); o[2] = p0[2] + v0[2] * bf2f(gw.y & 0xffffu); o[3] = p0[3] + v0[3] * bf2f(gw.y >> 16);
                    o[4] = p1[0] + v1_[0] * bf2f(gw.z & 0xffffu); o[5] = p1[1] + v1_[1] * bf2f(gw.z >> 16); o[6] = p1[2] + v1_[2] * bf2f(gw.w & 0xffffu); o[7] = p1[3] + v1_[3] * bf2f(gw.w >> 16);
                    v4u w; w.x = cvt_pk_bf16(o[0], o[1]); w.y = cvt_pk_bf16(o[2], o[3]); w.z = cvt_pk_bf16(o[4], o[5]); w.w = cvt_pk_bf16(o[6], o[7]);
                    *(v4u*)(v + ((size_t)r * 1024 + c0)) = w;
                }
        }
    }
};
struct EpiRes {
    static constexpr bool PERM = false;
    float* res; const float* bias; const float* g1;
    __device__ __forceinline__ void operator()(EPI_ARGS) const {
        const int col0 = u.pn * 256 + wc * 32 + 4 * fq;
#pragma unroll
        for (int bj = 0; bj < 2; ++bj)
#pragma unroll
            for (int n = 0; n < 2; ++n) {
                const f32x4 bv = *(const f32x4*)(bias + col0 + bj * 128 + n * 16), gv = *(const f32x4*)(g1 + col0 + bj * 128 + n * 16);
#pragma unroll
                for (int ai = 0; ai < 2; ++ai)
#pragma unroll
                    for (int m = 0; m < 4; ++m) { float* p = res + (size_t)(u.pm * 256 + ai * 128 + wr * 64 + m * 16 + fr) * 1024 + col0 + bj * 128 + n * 16;
                        const f32x4 h = *(const f32x4*)p; *(f32x4*)p = h * DN_ALPHA + gv * (acc[ai][bj][m][n] + bv); }
            }
    }
};
struct EpiDown {
    static constexpr bool PERM = true;
    bf16* y2; const float* bias; const int* srow; const float* sgate;
    __device__ __forceinline__ void operator()(EPI_ARGS) const {
        const float* bb = bias + (size_t)u.aux * 1024;
#pragma unroll
        for (int ai = 0; ai < 2; ++ai)
#pragma unroll
            for (int m = 0; m < 4; ++m) {
                const int d = u.pm * 256 + ai * 128 + wr * 64 + m * 16 + fr, sr = srow[d]; const float gs = sgate[d];
                if (sr >= 0) {
#pragma unroll
                    for (int bj = 0; bj < 2; ++bj) {
                        const int c0 = u.pn * 256 + bj * 128 + wc * 32 + 8 * fq;
                        const f32x4 v0 = (acc[ai][bj][m][0] + *(const f32x4*)(bb + c0)) * gs, v1 = (acc[ai][bj][m][1] + *(const f32x4*)(bb + c0 + 4)) * gs;
                        v4u w; w.x = cvt_pk_bf16(v0[0], v0[1]); w.y = cvt_pk_bf16(v0[2], v0[3]); w.z = cvt_pk_bf16(v1[0], v1[1]); w.w = cvt_pk_bf16(v1[2], v1[3]);
                        *(v4u*)(y2 + ((size_t)sr * 1024 + c0)) = w;
                    }
                }
            }
    }
};

__global__ void __launch_bounds__(NWAVES * 64, 2) mk_fwd(Args args) {
    extern __shared__ __attribute__((aligned(16))) unsigned char lds_raw[];
    LAS unsigned char* lds = (LAS unsigned char*)lds_raw;
    volatile LAS unsigned* MISC = (volatile LAS unsigned*)(lds + MISC_OFF);
    {
        const int tid0 = threadIdx.x;
        for (int u = tid0; u < (LDS_BYTES - LDSCTL_OFF) / 4; u += NWAVES * 64) ((LAS unsigned*)(lds + LDSCTL_OFF))[u] = 0u;
    }
    __syncthreads();
    XcdBarrier bar = xcd_barrier_post((unsigned*)(args.ws + WS_CTL) + CW_BAR, MISC + 8);
#define GRID_BAR() xcd_barrier(bar)
    typedef __attribute__((address_space(4))) const unsigned long long karg_t;
#define INP(i) ((const float*)KA[i])
#define PH_BEGIN() int tid = threadIdx.x; asm volatile("" : "+v"(tid)); const int lane = tid & 63, wave = __builtin_amdgcn_readfirstlane(tid >> 6); \
    int G = gridDim.x, b = blockIdx.x; asm volatile("" : "+s"(G), "+s"(b)); karg_t* KA = (karg_t*)__builtin_amdgcn_kernarg_segment_ptr(); asm volatile("" : "+s"(KA)); unsigned char* ws = (unsigned char*)KA[N_IN + 1]; \
    const int gw = b * NWAVES + wave, NGW = G * NWAVES, gt_ = b * (NWAVES * 64) + tid, NGT = G * NWAVES * 64; (void)lane; (void)gw; (void)NGW; (void)gt_; (void)NGT; (void)ws
#define MODP ((float*)(ws + WS_MODP))
#define MOD ((float*)(ws + WS_MOD))
#define POS ((float*)(ws + WS_POS))
#define TW ((float*)(ws + WS_TW))
#define PCS ((float*)(ws + WS_PCS))
#define ECTX ((float*)(ws + WS_ECTX))
#define ZP ((float*)(ws + WS_ZP))
#define BIASP1 ((float*)(ws + WS_BIASP1))
#define WRI ((float*)(ws + WS_WRI))
#define EID ((int*)(ws + WS_EID))
#define GATE ((float*)(ws + WS_GATE))
#define HIST ((int*)(ws + WS_HIST))
#define SROW ((int*)(ws + WS_SROW))
#define SGATE ((float*)(ws + WS_SGATE))
#define TEXP ((int*)(ws + WS_TEXP))
#define AB ((float*)(ws + WS_AB))
#define BB ((float*)(ws + WS_BB))
#define KT ((float*)(ws + WS_KT))
#define WGLU ((bf16*)(ws + WS_WGLU))
#define WBRS ((bf16*)(ws + WS_WBRS))
#define WBRF ((bf16*)(ws + WS_WBRF))
#define WOUT ((bf16*)(ws + WS_WOUT))
#define WDFT ((bf16*)(ws + WS_WDFT))
#define WUP ((bf16*)(ws + WS_WUP))
#define WDN ((bf16*)(ws + WS_WDN))
#define RES ((float*)(ws + WS_RES))
#define UB ((bf16*)(ws + WS_UB))
#define WIN ((bf16*)(ws + WS_WIN))
#define MYT ((bf16*)(ws + WS_MYT))
#define MET ((bf16*)(ws + WS_MET))
#define ACAT ((bf16*)(ws + WS_ACAT))
#define A1 ((bf16*)(ws + WS_A1))
#define A2 ((bf16*)(ws + WS_A2))
#define EBUF ((float*)(ws + WS_E))
#define GT ((bf16*)(ws + WS_GT))
#define Y5 ((bf16*)(ws + WS_Y5))
#define ZR ((bf16*)(ws + WS_ZR))
#define Z5 ((bf16*)(ws + WS_Z5))
#define V1 ((float*)(ws + WS_V1))
#define VB ((bf16*)(ws + WS_V))
#define XS ((bf16*)(ws + WS_XS))
#define ACT ((bf16*)(ws + WS_ACT))
#define Y2 ((bf16*)(ws + WS_Y2))


#ifndef DBG_STOP
#define DBG_STOP -1
#endif
#ifndef DBG_SUB
#define DBG_SUB 0
#endif
#define DBG_DUMP(n) do { if (DBG_STOP == (n)) { PH_BEGIN(); float* o_ = ((float*)KA[N_IN]); \
        for (size_t i_ = (size_t)gt_; i_ < (size_t)SEQ * DM; i_ += (size_t)NGT) { float v_ = 0.f; \
            if ((n) == 0) v_ = bf2f(WIN[i_ % (size_t)(3072 * 1024)]) + bf2f(WUP[i_ * 4]) + bf2f(WDN[i_ * 2]) + MODP[i_ % 196608] + POS[i_ & 131071] + AB[i_ % 270336] + BB[i_ & 131071] + TW[i_ & 32767] + bf2f(WDFT[i_ & 65535]) + bf2f(WGLU[i_ & 524287]) + bf2f(WOUT[i_ & 1048575]) + WRI[i_ & 32767] + BIASP1[i_ % 3072]; \
            if ((n) == 1) v_ = RES[i_] + bf2f(UB[i_]) + PCS[i_ & 131071] + KT[i_ & 524287]; \
            if ((n) == 2) v_ = DBG_SUB == 0 ? bf2f(GT[i_]) + bf2f(GT[i_ + (size_t)SEQ * DM]) : DBG_SUB == 1 ? bf2f(ACAT[(i_ & 16383) * 768 + ((i_ >> 14) & 511)]) : DBG_SUB == 2 ? bf2f(A1[i_ & 8388607]) : DBG_SUB == 4 ? bf2f(WIN[i_ % (size_t)(3072 * 1024)]) + BIASP1[i_ % 3072] : DBG_SUB == 5 ? bf2f(UB[i_]) : bf2f(MYT[i_ % (size_t)(NG * 512 * 768)]) + bf2f(MET[i_ & 4194303]); \
            if ((n) == 3) v_ = bf2f(A2[i_ & 8388607]) + EBUF[i_ & 4194303] + ECTX[i_ & 65535]; \
            if ((n) == 4) v_ = bf2f(ZR[i_ & 8388607]) + bf2f(ACAT[i_ % (size_t)(NG * NCH * 768)]); \
            if ((n) == 5) v_ = bf2f(ZR[i_ & 8388607]) + bf2f(Y5[i_ & 8388607]); \
            if ((n) == 6) v_ = bf2f(Z5[i_ & 8388607]); \
            if ((n) == 7) v_ = bf2f(VB[i_]); \
            if ((n) == 8 || (n) == 9) v_ = RES[i_] + ((n) == 9 ? bf2f(UB[i_]) + GATE[i_ & 65535] : 0.f); \
            if ((n) == 10) v_ = bf2f(XS[i_]) + SGATE[i_ & 65535] + (float)SROW[i_ & 65535] * 1e-3f; \
            if ((n) == 11) v_ = bf2f(ACT[i_]); \
            if ((n) == 12) v_ = bf2f(Y2[i_]) + bf2f(Y2[i_ + (size_t)SEQ * DM]) + bf2f(Y2[i_ + 2 * (size_t)SEQ * DM]) + bf2f(Y2[i_ + 3 * (size_t)SEQ * DM]); \
            o_[i_] = v_; } return; } } while (0)

    if (PHMASK & (1u << 0))    { PH_BEGIN();
        for (int it = b; it < 256; it += G) {
            const int kc = it & 15, nc = it >> 4;
            if (tid < 384) {
                const int n = nc * 384 + tid; float a0 = 0.f, a1 = 0.f;
                const float* w = INP(I_WADA) + (size_t)(kc * 64) * 6144 + n;
                for (int k = 0; k < 64; ++k) { const float cv = INP(I_C)[kc * 64 + k], cc = INP(I_CCTX)[kc * 64 + k]; const float wv = w[(size_t)k * 6144];
                    a0 += cv * sigmoidf_(cv) * wv; a1 += cc * sigmoidf_(cc) * wv; }
                MODP[(kc * 2 + 0) * 6144 + n] = a0; MODP[(kc * 2 + 1) * 6144 + n] = a1;
            }
        }
        for (int it = gt_; it < 256 * 256; it += NGT) {
            const int p = it >> 8, i = it & 255;
            const float om = (float)(1.0 / pow(10000.0, (double)i / 256.0)); const float ang = (float)p * om;
            POS[p * 512 + i] = (float)sin((double)ang); POS[p * 512 + 256 + i] = (float)cos((double)ang);
        }
        for (int it = gt_; it < 2 * NG * NP; it += NGT) {
            const int gd = it >> 6, p = it & 63;
            const double lr = INP(I_LAMRE)[it], li = INP(I_LAMIM)[it], dt = exp((double)INP(I_LOGDT)[gd]);
            for (int k = 0; k <= 32; ++k) { const double mg = exp(lr * dt * k), an = li * dt * k; AB[((size_t)it * 33 + k) * 2] = (float)(mg * cos(an)); AB[((size_t)it * 33 + k) * 2 + 1] = (float)(mg * sin(an)); }
            const double are = exp(lr * dt) * cos(li * dt), aim = exp(lr * dt) * sin(li * dt), den = lr * lr + li * li, nr = are - 1.0;
            const double kre = (nr * lr + aim * li) / den, kim = (aim * lr - nr * li) / den;
            for (int h = 0; h < 16; ++h) { const double br = INP(I_BRE)[(size_t)it * 16 + h], bi = INP(I_BIM)[(size_t)it * 16 + h];
                BB[((size_t)it * 16 + h) * 2] = (float)(kre * br - kim * bi); BB[((size_t)it * 16 + h) * 2 + 1] = (float)(kre * bi + kim * br); }
        }
        for (int it = gt_; it < 128 * 128; it += NGT) { const int n2 = it >> 7, m1 = it & 127; const double a = -2.0 * (double)((m1 * n2) & 16383) / 16384.0;
            TW[it * 2] = (float)cospi(a); TW[it * 2 + 1] = (float)sinpi(a); }
        for (int it = gt_; it < 128 * 128; it += NGT) { const int m = it >> 7, n = it & 127; const double a = 2.0 * (double)((m * n) & 127) / 128.0, s = 0.08838834764831845;
            const float c = (float)(cospi(a) * s), sn = (float)(sinpi(a) * s);
            WDFT[(2 * m) * 256 + 2 * n] = (bf16)f2bf(c); WDFT[(2 * m) * 256 + 2 * n + 1] = (bf16)f2bf(sn); WDFT[(2 * m + 1) * 256 + 2 * n] = (bf16)f2bf(-sn); WDFT[(2 * m + 1) * 256 + 2 * n + 1] = (bf16)f2bf(c); }
        for (int it = gt_; it < 1024 * 32; it += NGT) { const int k = it >> 5, e = it & 31; WRI[((k >> 2) * 32 + e) * 4 + (k & 3)] = INP(I_WR)[it]; }
        for (int it = gt_; it < 3072; it += NGT) if (it < 512 || it >= 1024) BIASP1[it] = INP(I_BIN)[it];
        {
            LAS float* scr = (LAS float*)(lds + wave * 16384);
            constexpr int I_IN = 16 * 80, I_GLU = 8 * 32, I_BRS = 8 * 32, I_BRF = 8 * 32, I_OUT = 16 * 32, I_UP1 = 16 * 64, I_DN1 = 16 * 32;
            constexpr int NIT = I_IN + I_GLU + I_BRS + I_BRF + I_OUT + NEXP * (I_UP1 + I_DN1);
            for (int it = gw; it < NIT; it += NGW) {
                int r = it;
                if (r < I_IN) { const int kb = r / 80, nb = r % 80, n0 = nb < 16 ? 32 * nb : 1024 + 32 * (nb - 16); transpose_item(INP(I_WIN), 1024, 3072, WIN, 64 * kb, n0, n0, scr, lane); continue; } r -= I_IN;
                if (r < I_GLU) { const int kb = r / 32, nb = r % 32; transpose_item(INP(I_WGLU), 512, 1024, WGLU, 64 * kb, 32 * nb, paired_row(32 * nb, 512), scr, lane); continue; } r -= I_GLU;
                if (r < I_BRS) { const int kb = r / 32, nb = r % 32; transpose_item(INP(I_WBRS), 512, 1024, WBRS, 64 * kb, 32 * nb, 32 * nb, scr, lane); continue; } r -= I_BRS;
                if (r < I_BRF) { const int kb = r / 32, nb = r % 32; transpose_item(INP(I_WBRF), 512, 1024, WBRF, 64 * kb, 32 * nb, 32 * nb, scr, lane); continue; } r -= I_BRF;
                if (r < I_OUT) { const int kb = r / 32, nb = r % 32; transpose_item(INP(I_WOUT), 1024, 1024, WOUT, 64 * kb, 32 * nb, 32 * nb, scr, lane); continue; } r -= I_OUT;
                if (r < NEXP * I_UP1) { const int e = r / I_UP1, q = r % I_UP1, kb = q / 64, nb = q % 64;
                    transpose_item(INP(I_WUP) + (size_t)e * 1024 * 2048, 1024, 2048, WUP + (size_t)e * 2048 * 1024, 64 * kb, 32 * nb, paired_row(32 * nb, 1024), scr, lane); continue; } r -= NEXP * I_UP1;
                { const int e = r / I_DN1, q = r % I_DN1, kb = q / 32, nb = q % 32;
                    transpose_item(INP(I_WDN) + (size_t)e * 1024 * 1024, 1024, 1024, WDN + (size_t)e * 1024 * 1024, 64 * kb, 32 * nb, 32 * nb, scr, lane); }
            }
        }
        __syncthreads();
        {
            LAS float* fc = (LAS float*)lds;
            LAS float* wrow = (LAS float*)(lds + 65536);
            bool have_fc = false;
            for (int it = b; it < 129; it += G) {
                if (!have_fc) {
                    for (int q = tid; q < 128 * 128; q += NWAVES * 64) { const int c = q >> 7, jj = q & 127, j = jj >> 1, part = jj & 1; const double s = 0.08838834764831845; double v;
                        if (j == 0) v = part ? ((c & 1) ? -s : s) : s; else { const double a = 2.0 * (double)((j * c) & 127) / 128.0; v = part ? -sinpi(a) * s : cospi(a) * s; }
                        fc[q] = (float)v; }
                    have_fc = true;
                }
                __syncthreads();
                for (int q = tid; q < 8 * 512; q += NWAVES * 64) { const int kk = q >> 9, n = q & 511; wrow[q] = it < 128 ? INP(I_WIN)[(size_t)(it * 8 + kk) * 3072 + 512 + n] : (kk == 0 ? INP(I_BIN)[512 + n] : 0.f); }
                __syncthreads();
                const int g = tid >> 7, jj = tid & 127; float a8[8];
#pragma unroll
                for (int kk = 0; kk < 8; ++kk) a8[kk] = 0.f;
                for (int c = 0; c < 128; ++c) { const float f = fc[c * 128 + jj];
#pragma unroll
                    for (int kk = 0; kk < 8; ++kk) a8[kk] += wrow[kk * 512 + g * 128 + c] * f; }
                if (it < 128) { v4u o; o.x = pk2(a8[0], a8[1]); o.y = pk2(a8[2], a8[3]); o.z = pk2(a8[4], a8[5]); o.w = pk2(a8[6], a8[7]);
                    *(v4u*)(WIN + ((size_t)(512 + tid) * 1024 + it * 8)) = o; }
                else BIASP1[512 + tid] = a8[0];
                __syncthreads();
            }
        }
    }
    GRID_BAR();
    DBG_DUMP(0);

    if (PHMASK & (1u << 1))    { PH_BEGIN();
        LAS float* sm = (LAS float*)lds;
        for (int q = tid; q < 4096; q += NWAVES * 64) { const int v = q >> 11, n = q & 2047; float s = INP(I_BADA)[n];
            for (int kc = 0; kc < 16; ++kc) s += MODP[(kc * 2 + v) * 6144 + n];
            sm[q] = s; }
        for (int q = gt_; q < 2 * 6144; q += NGT) { const int v = q / 6144, n = q % 6144; float s = INP(I_BADA)[n];
            for (int kc = 0; kc < 16; ++kc) s += MODP[(kc * 2 + v) * 6144 + n];
            MOD[q] = s; }
        __syncthreads();
        for (int t = gw; t < SEQ; t += NGW) {
            const int rp = t >> 6, cp = t & 63, row = row_of_tok(t);
            const f32x4* xr = (const f32x4*)(INP(I_X) + (size_t)t * 1024) + lane;
            f32x4 v[4]; float s = 0.f;
#pragma unroll
            for (int j = 0; j < 4; ++j) { const int e0 = 256 * j + 4 * lane; const f32x4 pe = *(const f32x4*)(POS + (j < 2 ? rp * 512 + e0 : cp * 512 + e0 - 512));
                v[j] = xr[64 * j] + pe; s += (v[j][0] + v[j][1]) + (v[j][2] + v[j][3]); }
            const float mean = wave_sum(s) * (1.f / 1024.f); float s2 = 0.f;
#pragma unroll
            for (int j = 0; j < 4; ++j) { v[j] = v[j] - mean; s2 += (v[j][0] * v[j][0] + v[j][1] * v[j][1]) + (v[j][2] * v[j][2] + v[j][3] * v[j][3]); }
            const float rstd = 1.f / sqrtf(wave_sum(s2) * (1.f / 1024.f) + LN_EPS);
#pragma unroll
            for (int j = 0; j < 4; ++j) { const int e0 = 256 * j + 4 * lane;
                const f32x4 gg = *(const f32x4*)(INP(I_LNING) + e0), bb = *(const f32x4*)(INP(I_LNINB) + e0);
                const f32x4 h = v[j] * rstd * gg + bb;
                *(f32x4*)(RES + (size_t)row * 1024 + e0) = h;
                const f32x4 sh = *(const LAS f32x4*)(sm + e0), sc = *(const LAS f32x4*)(sm + 1024 + e0);
                const f32x4 uu = h * (sc + 1.0f) + sh;
                v2u o; o.x = pk2(uu[0], uu[1]); o.y = pk2(uu[2], uu[3]);
                *(v2u*)(UB + (size_t)row * 1024 + e0) = o; }
        }
        for (int it = gt_; it < 2 * NG * 32 * 256; it += NGT) {
            const int hp = it & 15, h = (it >> 4) & 15, lag = (it >> 8) & 31, gd = it >> 13;
            const float* cr = INP(I_CRE) + ((size_t)gd * 16 + h) * 64; const float* ci = INP(I_CIM) + ((size_t)gd * 16 + h) * 64;
            float s = 0.f;
            for (int p = 0; p < 64; ++p) { const float ar = AB[((size_t)(gd * 64 + p) * 33 + lag) * 2], ai = AB[((size_t)(gd * 64 + p) * 33 + lag) * 2 + 1];
                const float br = BB[((size_t)(gd * 64 + p) * 16 + hp) * 2], bi = BB[((size_t)(gd * 64 + p) * 16 + hp) * 2 + 1];
                const float xr_ = ar * br - ai * bi, xi_ = ar * bi + ai * br;
                s += cr[p] * xr_ - ci[p] * xi_; }
            KT[it] = s;
        }
        __syncthreads();
        LAS float* ucl = (LAS float*)(lds + 16384);
        for (int it = b; it < 256; it += G) {
            const int tg = it >> 4, cg = it & 15;
            __syncthreads();
            for (int rr = wave * 2; rr < wave * 2 + 2; ++rr) {
                const int t = tg * 16 + rr; const f32x4* xr = (const f32x4*)(INP(I_CTX) + (size_t)t * 1024) + lane;
                f32x4 v[4]; float s = 0.f;
#pragma unroll
                for (int j = 0; j < 4; ++j) { v[j] = xr[64 * j]; s += (v[j][0] + v[j][1]) + (v[j][2] + v[j][3]); }
                const float mean = wave_sum(s) * (1.f / 1024.f); float s2 = 0.f;
#pragma unroll
                for (int j = 0; j < 4; ++j) { v[j] = v[j] - mean; s2 += (v[j][0] * v[j][0] + v[j][1] * v[j][1]) + (v[j][2] * v[j][2] + v[j][3] * v[j][3]); }
                const float rstd = 1.f / sqrtf(wave_sum(s2) * (1.f / 1024.f) + LN_EPS);
#pragma unroll
                for (int j = 0; j < 4; ++j) { const int e0 = 256 * j + 4 * lane;
                    const f32x4 gg = *(const f32x4*)(INP(I_LNING) + e0), bb = *(const f32x4*)(INP(I_LNINB) + e0);
                    const f32x4 h = v[j] * rstd * gg + bb;
                    const f32x4 sh = *(const LAS f32x4*)(sm + 2048 + e0), sc = *(const LAS f32x4*)(sm + 3072 + e0);
                    *(LAS f32x4*)(ucl + rr * 1024 + e0) = h * (sc + 1.0f) + sh; }
            }
            __syncthreads();
            const int tt = tid >> 5, n = cg * 32 + (tid & 31); float a = 0.f;
            const float* w = INP(I_WIN) + n;
            for (int k = 0; k < 1024; k += 4) { const f32x4 uv = *(const LAS f32x4*)(ucl + tt * 1024 + k);
                a += uv[0] * w[(size_t)k * 3072] + uv[1] * w[(size_t)(k + 1) * 3072] + uv[2] * w[(size_t)(k + 2) * 3072] + uv[3] * w[(size_t)(k + 3) * 3072]; }
            PCS[(tg * 16 + tt) * 512 + n] = a + INP(I_BIN)[n];
        }
    }
    GRID_BAR();
    DBG_DUMP(1);

    if (PHMASK & (1u << 2))    { PH_BEGIN();
        for (int it = gt_; it < NG * 512 * 96; it += NGT) {
            const int kb = it % 96, nrow = (it / 96) & 511, g = it / (96 * 512), tau = nrow >> 4, h = nrow & 15;
            float o[8];
            if (kb < 64) { const int j = kb >> 1, hp0 = (kb & 1) * 8;
                if (j < tau) { const float* kp = KT + ((size_t)((0 * NG + g) * 32 + (tau - j)) * 16 + h) * 16 + hp0;
#pragma unroll
                    for (int i = 0; i < 8; ++i) o[i] = kp[i]; }
                else if (j > tau) { const float* kp = KT + ((size_t)((1 * NG + g) * 32 + (j - tau)) * 16 + h) * 16 + hp0;
#pragma unroll
                    for (int i = 0; i < 8; ++i) o[i] = kp[i]; }
                else { const float* kf = KT + ((size_t)((0 * NG + g) * 32 + 0) * 16 + h) * 16 + hp0; const float* kb_ = KT + ((size_t)((1 * NG + g) * 32 + 0) * 16 + h) * 16 + hp0;
#pragma unroll
                    for (int i = 0; i < 8; ++i) o[i] = kf[i] + kb_[i] + ((hp0 + i) == h ? INP(I_S5D)[g * 16 + h] : 0.f); }
            } else { const int q = kb - 64, d = q >> 4, part = (q >> 3) & 1, p0 = (q & 7) * 8, gd = d * NG + g, lag = d == 0 ? tau + 1 : 32 - tau;
#pragma unroll
                for (int i = 0; i < 8; ++i) { const int p = p0 + i; const float cr = INP(I_CRE)[((size_t)gd * 16 + h) * 64 + p], ci = INP(I_CIM)[((size_t)gd * 16 + h) * 64 + p];
                    const float ar = AB[((size_t)(gd * 64 + p) * 33 + lag) * 2], ai = AB[((size_t)(gd * 64 + p) * 33 + lag) * 2 + 1];
                    o[i] = part == 0 ? (cr * ar - ci * ai) : -(cr * ai + ci * ar); } }
            v4u w; w.x = pk2(o[0], o[1]); w.y = pk2(o[2], o[3]); w.z = pk2(o[4], o[5]); w.w = pk2(o[6], o[7]);
            *(v4u*)(MYT + ((size_t)(g * 512 + nrow) * 768 + kb * 8)) = w;
        }
        for (int it = gt_; it < NG * 256 * 64; it += NGT) {
            const int kb = it & 63, qq = (it >> 6) & 255, g = it >> 14, j = kb >> 1, hp0 = (kb & 1) * 8, d = qq >> 7, part = (qq >> 6) & 1, p = qq & 63, gd = d * NG + g, lag = d == 0 ? 31 - j : j;
            const float ar = AB[((size_t)(gd * 64 + p) * 33 + lag) * 2], ai = AB[((size_t)(gd * 64 + p) * 33 + lag) * 2 + 1]; float o[8];
#pragma unroll
            for (int i = 0; i < 8; ++i) { const float br = BB[((size_t)(gd * 64 + p) * 16 + hp0 + i) * 2], bi = BB[((size_t)(gd * 64 + p) * 16 + hp0 + i) * 2 + 1]; o[i] = part == 0 ? (ar * br - ai * bi) : (ar * bi + ai * br); }
            v4u w; w.x = pk2(o[0], o[1]); w.y = pk2(o[2], o[3]); w.z = pk2(o[4], o[5]); w.w = pk2(o[6], o[7]);
            *(v4u*)(MET + ((size_t)(g * 256 + qq) * 512 + kb * 8)) = w;
        }
        __syncthreads();
        pg8::Gemm gm{UB, WIN, 1024, 1024, 1024}; pg8::StaticOrder S; S.init(SEQ, 3072, G, b);
        EpiP1 E{BIASP1, ACAT, A1, GT};
#ifdef DBG_ONEUNIT
        for (int ui_ = 0; ui_ < 3; ++ui_) { pg8::OneUnit<pg8::StaticOrder> S1{S, ui_}; pg8::gemm_phase<EpiP1, pg8::OneUnit<pg8::StaticOrder>, true>(lds, gm, S1, E, tid); }
#else
        pg8::gemm_phase<EpiP1, pg8::StaticOrder, true>(lds, gm, S, E, tid);
#endif
    }
    GRID_BAR();
    DBG_DUMP(2);

    if (PHMASK & (1u << 3))    { PH_BEGIN();
        { pg8::Gemm gm{A1, WDFT, 256, 256, 256}; pg8::GroupOrder S; S.init(128, 1, 1, G, b, 0); S.shareB = 1; EpiF1 E{TW, A2};
          pg8::gemm_phase<EpiF1, pg8::GroupOrder, true>(lds, gm, S, E, tid); }
        { pg8::Gemm gm{ACAT, MET, 512, 768, 512}; pg8::GroupOrder S; S.init(NG, 2, 1, G, b, 128); S.shareB = 0; EpiE E{EBUF};
          pg8::gemm_phase<EpiE, pg8::GroupOrder, true>(lds, gm, S, E, tid); }
        if (G < 256 || b >= 192) {
            const int nb = G < 256 ? G : 64, bi = G < 256 ? b : b - 192;
            for (int it = bi * 512 + tid; it < NG * NCC * 256; it += nb * 512) {
                const int qq = it & 255, cc = (it >> 8) & 7, g = it >> 11; float s = 0.f;
                const bf16* mr = MET + (size_t)(g * 256 + qq) * 512;
                for (int k = 0; k < 512; ++k) s += bf2f(mr[k]) * PCS[(cc * 32 + (k >> 4)) * 512 + g * 16 + (k & 15)];
                ECTX[it] = s;
            }
        }
    }
    GRID_BAR();
    DBG_DUMP(3);

    if (PHMASK & (1u << 4))    { PH_BEGIN();
        { pg8::Gemm gm{A2, WDFT, 256, 256, 256}; pg8::GroupOrder S; S.init(128, 1, 1, G, b, 0); S.shareB = 1; EpiF2 E{ZR, ZP};
          pg8::gemm_phase<EpiF2, pg8::GroupOrder, true>(lds, gm, S, E, tid); }
        {
            const int nb = G < 256 ? G : 8, bi = G < 256 ? b : b - 128;
            if (bi >= 0 && bi < nb)
            for (int ch = bi * 512 + tid; ch < 2 * NG * NP; ch += nb * 512) {
                const int p = ch & 63, g = (ch >> 6) & 31, d = ch >> 11, gd = d * NG + g;
                const float Ar = AB[((size_t)(gd * 64 + p) * 33 + 32) * 2], Ai = AB[((size_t)(gd * 64 + p) * 33 + 32) * 2 + 1];
                float sr = 0.f, si = 0.f;
                for (int i = 0; i < NCC; ++i) { const int cc = d == 0 ? i : NCC - 1 - i; const float er = ECTX[(g * NCC + cc) * 256 + d * 128 + p], ei = ECTX[(g * NCC + cc) * 256 + d * 128 + 64 + p];
                    const float nr = Ar * sr - Ai * si + er, ni = Ar * si + Ai * sr + ei; sr = nr; si = ni; }
                for (int i0 = 0; i0 < NCH; i0 += 16) {
                    float er[16], ei[16];
#pragma unroll
                    for (int q = 0; q < 16; ++q) { const int c = d == 0 ? i0 + q : NCH - 1 - (i0 + q);
                        er[q] = EBUF[(size_t)(g * NCH + c) * 256 + d * 128 + p]; ei[q] = EBUF[(size_t)(g * NCH + c) * 256 + d * 128 + 64 + p]; }
#pragma unroll
                    for (int q = 0; q < 16; ++q) { const int c = d == 0 ? i0 + q : NCH - 1 - (i0 + q);
                        bf16* ap = ACAT + (size_t)(g * NCH + c) * 768 + 512 + d * 128 + p; ap[0] = (bf16)f2bf(sr); ap[64] = (bf16)f2bf(si);
                        const float nr = Ar * sr - Ai * si + er[q], ni = Ar * si + Ai * sr + ei[q]; sr = nr; si = ni; }
                }
            }
        }
    }
    GRID_BAR();
    DBG_DUMP(4);

    if (PHMASK & (1u << 5))    { PH_BEGIN();
        { pg8::Gemm gm{ACAT, MYT, 768, 768, 768}; pg8::GroupOrder S; S.init(NG, 2, 2, G, b, 0); S.shareB = 0; EpiY5 E{Y5};
          pg8::gemm_phase<EpiY5, pg8::GroupOrder, true>(lds, gm, S, E, tid); }
        if (G < 256 || b >= 128) {
            const int nb = G < 256 ? G : 128, bi = G < 256 ? b : b - 128;
            for (int it = bi * 512 + tid; it < SEQ * 4; it += nb * 512) {
                const int g = it & 3, r = it >> 2, m1 = r >> 7, m2 = r & 127, m1p = m1 > 0 ? 128 - m1 : 0, m2p = m1 > 0 ? 127 - m2 : ((128 - m2) & 127), rp = m1p * 128 + m2p;
                const f32x2 a = *(const f32x2*)(ZP + ((size_t)r * 4 + g) * 2), c = *(const f32x2*)(ZP + ((size_t)rp * 4 + g) * 2);
                ZR[(size_t)r * 512 + g * 128] = (bf16)f2bf(0.5f * (a[0] + c[0])); ZR[(size_t)r * 512 + g * 128 + 64] = (bf16)f2bf(0.5f * (a[1] + c[1]));
            }
        }
    }
    GRID_BAR();
    DBG_DUMP(5);

    if (PHMASK & (1u << 6))    { PH_BEGIN(); pg8::Gemm gm{Y5, WGLU, 512, 512, 512}; pg8::StaticOrder S; S.init(SEQ, 1024, G, b); EpiPair<0> E{Z5, 512, INP(I_BGLU), 512};
      pg8::gemm_phase<EpiPair<0>, pg8::StaticOrder, true>(lds, gm, S, E, tid); }
    GRID_BAR();
    DBG_DUMP(6);

    if (PHMASK & (1u << 7))    { PH_BEGIN(); pg8::Gemm gm{Z5, WBRS, 512, 512, 512}; pg8::StaticOrder S; S.init(SEQ, 1024, G, b); EpiV1 E{V1, GT};
      pg8::gemm_phase<EpiV1, pg8::StaticOrder, true>(lds, gm, S, E, tid); }
    if (PHMASK & (1u << 7))    { PH_BEGIN(); pg8::Gemm gm{ZR, WBRF, 512, 512, 512}; pg8::StaticOrder S; S.init(SEQ, 1024, G, b); EpiV E{V1, GT, INP(I_BBRF), VB};
      pg8::gemm_phase<EpiV, pg8::StaticOrder, true>(lds, gm, S, E, tid); }
    GRID_BAR();
    DBG_DUMP(7);

    if (PHMASK & (1u << 8))    { PH_BEGIN(); pg8::Gemm gm{VB, WOUT, 1024, 1024, 1024}; pg8::StaticOrder S; S.init(SEQ, 1024, G, b); EpiRes E{RES, INP(I_BOUT), MOD + 2 * 1024};
      pg8::gemm_phase<EpiRes, pg8::StaticOrder, true>(lds, gm, S, E, tid); }
    GRID_BAR();
    DBG_DUMP(8);

    if (PHMASK & (1u << 9))    { PH_BEGIN();
        LAS float* urow = (LAS float*)(lds + wave * 16384);
        LAS int* hist = (LAS int*)(lds + LDSCTL_OFF);
        const float* ln1g = INP(I_LN1G); const float* ln1b = INP(I_LN1B);
        const float* sh2 = MOD + 3 * 1024; const float* sc2 = MOD + 4 * 1024;
        for (int it = b; it < 256; it += G) {
            __syncthreads();
            if (tid < 32) hist[tid] = 0;
            __syncthreads();
            for (int half = 0; half < 2; ++half) {
                const int row0 = it * 64 + wave * 8 + half * 4;
#pragma unroll
                for (int i = 0; i < 4; ++i) {
                    float* rp = RES + (size_t)(row0 + i) * 1024;
                    f32x4 v[4]; float s = 0.f;
#pragma unroll
                    for (int j = 0; j < 4; ++j) { v[j] = *(const f32x4*)(rp + 256 * j + 4 * lane); s += (v[j][0] + v[j][1]) + (v[j][2] + v[j][3]); }
                    const float mean = wave_sum(s) * (1.f / 1024.f); float s2 = 0.f;
#pragma unroll
                    for (int j = 0; j < 4; ++j) { v[j] = v[j] - mean; s2 += (v[j][0] * v[j][0] + v[j][1] * v[j][1]) + (v[j][2] * v[j][2] + v[j][3] * v[j][3]); }
                    const float rstd = 1.f / sqrtf(wave_sum(s2) * (1.f / 1024.f) + LN_EPS);
#pragma unroll
                    for (int j = 0; j < 4; ++j) { const int e0 = 256 * j + 4 * lane;
                        const f32x4 h = v[j] * rstd * *(const f32x4*)(ln1g + e0) + *(const f32x4*)(ln1b + e0);
                        *(f32x4*)(rp + e0) = h;
                        const f32x4 uu = h * (*(const f32x4*)(sc2 + e0) + 1.0f) + *(const f32x4*)(sh2 + e0);
                        v2u o; o.x = pk2(uu[0], uu[1]); o.y = pk2(uu[2], uu[3]);
                        *(v2u*)(UB + (size_t)(row0 + i) * 1024 + e0) = o;
                        *(LAS f32x4*)(urow + i * 1024 + e0) = uu; }
                }
                LDS_WAIT(); asm volatile("" ::: "memory");
                const int e = lane & 31, kh = lane >> 5; float a4[4] = {0.f, 0.f, 0.f, 0.f};
                for (int kq = 0; kq < 128; ++kq) {
                    const int kk = kh * 128 + kq;
                    const f32x4 w = *(const f32x4*)(WRI + ((size_t)kk * 32 + e) * 4);
#pragma unroll
                    for (int i = 0; i < 4; ++i) { const f32x4 uv = *(const LAS f32x4*)(urow + i * 1024 + 4 * kk); a4[i] += (uv[0] * w[0] + uv[1] * w[1]) + (uv[2] * w[2] + uv[3] * w[3]); }
                }
                const float br = INP(I_BR)[e];
#pragma unroll
                for (int i = 0; i < 4; ++i) {
                    float lg = a4[i] + __shfl_xor(a4[i], 32) + br;
                    float tv[4]; int ti[4];
#pragma unroll
                    for (int r = 0; r < 4; ++r) {
                        float bv = lg; int bi_ = e;
#pragma unroll
                        for (int o = 1; o < 32; o <<= 1) { const float ov = __shfl_xor(bv, o); const int oi = __shfl_xor(bi_, o); if (ov > bv || (ov == bv && oi < bi_)) { bv = ov; bi_ = oi; } }
                        tv[r] = bv; ti[r] = bi_; if (e == bi_) lg = -3.0e38f;
                    }
                    const float e1 = __expf(tv[1] - tv[0]), e2 = __expf(tv[2] - tv[0]), e3 = __expf(tv[3] - tv[0]), inv = 1.0f / (1.0f + e1 + e2 + e3);
                    if (lane == 0) { const int row = row0 + i;
                        *(int4*)(EID + (size_t)row * 4) = make_int4(ti[0], ti[1], ti[2], ti[3]);
                        *(f32x4*)(GATE + (size_t)row * 4) = (f32x4){inv, e1 * inv, e2 * inv, e3 * inv};
                        __hip_atomic_fetch_add(&hist[ti[0]], 1, __ATOMIC_RELAXED, __HIP_MEMORY_SCOPE_WORKGROUP); __hip_atomic_fetch_add(&hist[ti[1]], 1, __ATOMIC_RELAXED, __HIP_MEMORY_SCOPE_WORKGROUP); __hip_atomic_fetch_add(&hist[ti[2]], 1, __ATOMIC_RELAXED, __HIP_MEMORY_SCOPE_WORKGROUP); __hip_atomic_fetch_add(&hist[ti[3]], 1, __ATOMIC_RELAXED, __HIP_MEMORY_SCOPE_WORKGROUP); }
                }
                LDS_WAIT(); asm volatile("" ::: "memory");
            }
            __syncthreads();
            if (tid < 32) HIST[it * 32 + tid] = hist[tid];
        }
    }
    GRID_BAR();
    DBG_DUMP(9);

    if (PHMASK & (1u << 10))    { PH_BEGIN();
        LAS int* sh = (LAS int*)lds;
        for (int it = b; it < 256; it += G) {
            __syncthreads();
            if (tid < 32) { int cnt = 0, bef = 0; for (int q = 0; q < 256; ++q) { const int h = HIST[q * 32 + tid]; cnt += h; bef += q < it ? h : 0; } sh[tid] = cnt; sh[64 + tid] = bef; }
            __syncthreads();
            if (tid == 0) { int tb = 0; for (int e = 0; e < 32; ++e) { sh[32 + e] = tb * 256; tb += (sh[e] + 255) >> 8; } sh[96] = tb; }
            __syncthreads();
            if (it < 32) {
                const int e = it, rb = sh[32 + e], cnt = sh[e], nt = (cnt + 255) >> 8;
                for (int q = tid; q < nt; q += NWAVES * 64) TEXP[(rb >> 8) + q] = e;
                for (int q = cnt + tid; q < nt * 256; q += NWAVES * 64) { SROW[rb + q] = -1; SGATE[rb + q] = 0.f; }
                if (e == 0 && tid == 0) TEXP[MAXTILES] = sh[96];
            }
            if (tid < 256) sh[128 + tid] = EID[(size_t)it * 256 + tid];
            __syncthreads();
            if (tid < 256) { const int e = sh[128 + tid]; int rank = 0; for (int q = 0; q < tid; ++q) rank += (sh[128 + q] == e) ? 1 : 0;
                const int dest = sh[32 + e] + sh[64 + e] + rank; sh[384 + tid] = dest;
                SROW[dest] = it * 256 + tid; SGATE[dest] = GATE[(size_t)it * 256 + tid]; }
            __syncthreads();
            for (int q = wave; q < 256; q += NWAVES) {
                const int row = it * 64 + (q >> 2), dest = sh[384 + q];
                const v4u* src = (const v4u*)(UB + (size_t)row * 1024); v4u* dst = (v4u*)(XS + (size_t)dest * 1024);
                const v4u x0 = src[lane], x1 = src[64 + lane]; dst[lane] = x0; dst[64 + lane] = x1;
            }
        }
    }
    GRID_BAR();
    DBG_DUMP(10);

    if (PHMASK & (1u << 11))    { PH_BEGIN(); const int ntiles = TEXP[MAXTILES];
      pg8::Gemm gm{XS, WUP, 1024, 1024, 1024}; pg8::MoeOrder<8> S{TEXP, ntiles, G, b}; EpiPair<1> E{ACT, 1024, INP(I_BUP), 1024};
      pg8::gemm_phase<EpiPair<1>, pg8::MoeOrder<8>, true>(lds, gm, S, E, tid); }
    GRID_BAR();
    DBG_DUMP(11);

    if (PHMASK & (1u << 12))    { PH_BEGIN(); const int ntiles = TEXP[MAXTILES];
      pg8::Gemm gm{ACT, WDN, 1024, 1024, 1024}; pg8::MoeOrder<4> S{TEXP, ntiles, G, b}; EpiDown E{Y2, INP(I_BDN), SROW, SGATE};
      pg8::gemm_phase<EpiDown, pg8::MoeOrder<4>, true>(lds, gm, S, E, tid); }
    GRID_BAR();
    DBG_DUMP(12);

    if (PHMASK & (1u << 13))    { PH_BEGIN();
        const float* g2 = MOD + 5 * 1024; const float* ln2g = INP(I_LN2G); const float* ln2b = INP(I_LN2B);
        for (int row = gw; row < SEQ; row += NGW) {
            const int t = row_of_tok(row);
            f32x4 v[4]; float s = 0.f;
#pragma unroll
            for (int j = 0; j < 4; ++j) { const int e0 = 256 * j + 4 * lane;
                f32x4 m = (f32x4){0.f, 0.f, 0.f, 0.f};
#pragma unroll
                for (int k = 0; k < 4; ++k) { const v2u y = *(const v2u*)(Y2 + ((size_t)row * 4 + k) * 1024 + e0);
                    m[0] += bf2f(y.x & 0xffffu); m[1] += bf2f(y.x >> 16); m[2] += bf2f(y.y & 0xffffu); m[3] += bf2f(y.y >> 16); }
                v[j] = *(const f32x4*)(RES + (size_t)row * 1024 + e0) * DN_ALPHA + *(const f32x4*)(g2 + e0) * m;
                s += (v[j][0] + v[j][1]) + (v[j][2] + v[j][3]); }
            const float mean = wave_sum(s) * (1.f / 1024.f); float s2 = 0.f;
#pragma unroll
            for (int j = 0; j < 4; ++j) { v[j] = v[j] - mean; s2 += (v[j][0] * v[j][0] + v[j][1] * v[j][1]) + (v[j][2] * v[j][2] + v[j][3] * v[j][3]); }
            const float rstd = 1.f / sqrtf(wave_sum(s2) * (1.f / 1024.f) + LN_EPS);
#pragma unroll
            for (int j = 0; j < 4; ++j) { const int e0 = 256 * j + 4 * lane;
                *(f32x4*)(((float*)KA[N_IN]) + (size_t)t * 1024 + e0) = v[j] * rstd * *(const f32x4*)(ln2g + e0) + *(const f32x4*)(ln2b + e0); }
        }
    }
#undef GRID_BAR
}

extern "C" void kernel_launch(void* const* d_in, const int* in_sizes, int n_in, void* d_out, int out_size, void* d_ws, size_t ws_size, hipStream_t stream) {
    static int grid = 0;
    if (grid == 0) {
        if (n_in != N_IN || out_size != SEQ * DM || ws_size < WS_END) { fprintf(stderr, "kernel_launch: unexpected problem (n_in %d, out %d, ws %zu)\n", n_in, out_size, ws_size); grid = -1; return; }
        int dev = 0, cus = 0, per_cu = 0;
        if (hipGetDevice(&dev) != hipSuccess || hipDeviceGetAttribute(&cus, hipDeviceAttributeMultiprocessorCount, dev) != hipSuccess) { fprintf(stderr, "kernel_launch: device query failed\n"); grid = -1; return; }
        if (hipFuncSetAttribute((const void*)mk_fwd, hipFuncAttributeMaxDynamicSharedMemorySize, LDS_BYTES) != hipSuccess) { fprintf(stderr, "kernel_launch: hipFuncSetAttribute failed\n"); grid = -1; return; }
        if (hipOccupancyMaxActiveBlocksPerMultiprocessor(&per_cu, (const void*)mk_fwd, NWAVES * 64, LDS_BYTES) != hipSuccess || per_cu < 1) { fprintf(stderr, "kernel_launch: occupancy query says %d\n", per_cu); per_cu = 1; }
        (void)hipGetLastError();
        grid = cus * (per_cu > 1 ? 1 : per_cu);
        if (grid > 256) grid = 256;
    }
    if (grid < 0) return;
    (void)hipMemsetAsync((char*)d_ws + WS_CTL, 0, CTL_ZERO_BYTES, stream);
    Args a{};
    for (int i = 0; i < N_IN; ++i) a.in[i] = (const float*)d_in[i];
    a.out = (float*)d_out; a.ws = (unsigned char*)d_ws;
    void* kargs[] = {&a};
    hipError_t e = hipLaunchCooperativeKernel((const void*)mk_fwd, dim3(grid), dim3(NWAVES * 64), kargs, LDS_BYTES, stream);
    if (e != hipSuccess) fprintf(stderr, "cooperative launch failed: %s (grid %d)\n", hipGetErrorString(e), grid);
}
```

```cpp
#include <hip/hip_runtime.h>
#include <cstdio>
#include <cstdint>

#define GAS __attribute__((address_space(1)))
#define LAS __attribute__((address_space(3)))
typedef unsigned short bf16;
typedef unsigned v4u __attribute__((ext_vector_type(4)));
typedef unsigned v2u __attribute__((ext_vector_type(2)));
typedef float f32x4 __attribute__((ext_vector_type(4)));
typedef float f32x2 __attribute__((ext_vector_type(2)));
typedef short bf16x8 __attribute__((ext_vector_type(8)));

namespace pg8 {
#define PG8_LAS __attribute__((address_space(3)))
constexpr int BM = 256, BK = 64, HALF = 128, HTB = HALF * BK * 2, STAGE_BYTES = 8 * HTB, NXCD = 8, WGM = 8;
__host__ __device__ __forceinline__ int lds_byte(int r, int c) { const int st = (r >> 4) * 2 + (c >> 5), rr = r & 15, cc = c & 31, ob = rr * 64 + cc * 2; return st * 1024 + (ob ^ (((ob >> 9) & 1) << 5)); }
__host__ __device__ __forceinline__ void stage_rc(int b, int& R, int& C) { const int st = b / 1024, sb = b % 1024, swz = sb ^ (((sb >> 9) & 1) << 5); R = (st >> 1) * 16 + swz / 64; C = (st & 1) * 32 + (swz % 64) / 2; }
__host__ __device__ __forceinline__ int perm32(int rho) { const int n = rho >> 4, i = rho & 15; return 8 * (i >> 2) + 4 * n + (i & 3); }

struct Unit { int pa, pb, pm, pn, aux, koff; };
struct Gemm { const bf16* A; const bf16* Bt; int K, lda, ldb; };

struct StaticOrder {
    int nM, nN, nwg, G, c;
    __device__ void init(int M, int N, int G_, int c_) { nM = M / BM; nN = N / BM; nwg = nM * nN; G = G_; c = c_; }
    __device__ bool next(int i, Unit& u) const {
        const long L = (long)i * G + c; if (L >= nwg) return false;
        int wgid = (int)L; { const int q = nwg / NXCD, r = nwg % NXCD, xcd = wgid % NXCD, off = wgid / NXCD; wgid = (xcd < r ? xcd * (q + 1) : r * (q + 1) + (xcd - r) * q) + off; }
        const int nig = WGM * nN, gid = wgid / nig, fm = gid * WGM, gsz = (nM - fm) < WGM ? (nM - fm) : WGM;
        u.pm = fm + ((wgid % nig) % gsz); u.pn = (wgid % nig) / gsz; u.pa = u.pm; u.pb = u.pn; u.aux = 0; u.koff = 0; return true;
    }
};
struct GroupOrder {
    int nG, nMg, nNg, G, c, shareB;
    __device__ void init(int nG_, int nMg_, int nNg_, int G_, int c_, int off) { nG = nG_; nMg = nMg_; nNg = nNg_; G = G_; c = (c_ - off % G_ + G_) % G_; }
    __device__ bool next(int i, Unit& u) const {
        const long L = (long)i * G + c; if (L >= (long)nG * nMg * nNg) return false;
        const int per = nMg * nNg, g = (int)L / per, r = (int)L % per;
        u.pm = r / nNg; u.pn = r % nNg; u.aux = g; u.pa = g * nMg + u.pm; u.pb = shareB ? u.pn : g * nNg + u.pn; u.koff = 0; return true;
    }
};
struct KSplitOrder {
    int NPN, KS, KSL, G, c;
    __device__ void init(int NPN_, int KS_, int KSL_, int G_, int c_, int off) { NPN = NPN_; KS = KS_; KSL = KSL_; G = G_; c = (c_ - off % G_ + G_) % G_; }
    __device__ bool next(int i, Unit& u) const {
        const long L = (long)i * G + c; if (L >= (long)NPN * KS) return false;
        const int ks = (int)L / NPN, pn = (int)L % NPN;
        u.pm = 0; u.pn = pn; u.aux = ks; u.pa = 0; u.pb = pn; u.koff = ks * KSL * 2; return true;
    }
};
template <int NPN> struct MoeOrder {
    const int* texp; int ntiles, G, c;
    __device__ bool next(int i, Unit& u) const {
        const long L = (long)i * G + c; if (L >= (long)ntiles * NPN) return false;
        const int tr = (int)(L / NPN), pn = (int)(L % NPN), e = texp[tr];
        u.pm = tr; u.pn = pn; u.aux = e; u.pa = tr; u.pb = e * NPN + pn; u.koff = 0; return true;
    }
};

template <class S> struct OneUnit { const S& s; int which; __device__ __forceinline__ bool next(int i, Unit& u) const { return i == 0 ? s.next(which, u) : false; } };

typedef __bf16 bf16x2_t __attribute__((ext_vector_type(2)));
__device__ __forceinline__ unsigned cvt_pk_bf16(float lo, float hi) { const f32x2 v = {lo, hi}; const bf16x2_t r = __builtin_convertvector(v, bf16x2_t); return __builtin_bit_cast(unsigned, r); }

template <class Epi, class Sched, bool ALIGN_EPI>
__device__ __forceinline__ void gemm_phase(PG8_LAS unsigned char* lds, const Gemm g, const Sched& S, const Epi& E, const int tid) {
    const int wid = __builtin_amdgcn_readfirstlane(tid >> 6), lane = tid & 63, wr = wid >> 2, wc = wid & 3, fr = lane & 15, fq = lane >> 4;
    int Kop = g.K; asm volatile("" : "+s"(Kop));
    const int nt = Kop / BK;
    unsigned voffA[2], voffB[2];
#pragma unroll
    for (int i = 0; i < 2; ++i) { int R, C; stage_rc(tid * 16 + i * 8192, R, C); const int Rb = Epi::PERM ? ((R & ~31) + perm32(R & 31)) : R;
        voffA[i] = (unsigned)(R * g.lda + C) * 2u; voffB[i] = (unsigned)(Rb * g.ldb + C) * 2u; }
    const size_t kstep = (size_t)(BK * 2);
    const size_t hstepA = (size_t)HALF * g.lda * 2, hstepB = (size_t)HALF * g.ldb * 2;
    const size_t tstepA = 2 * hstepA, tstepB = 2 * hstepB;
    const unsigned ldsw = (unsigned)wid * 1024u;
    const int aoff = lds_byte(wr * 64 + fr, fq * 8), boff = lds_byte(wc * 32 + fr, fq * 8);
#define PG8_SA(b, h) (((b) * 2 + (h)) * HTB)
#define PG8_SB(b, h) ((4 + (b) * 2 + (h)) * HTB)
#define PG8_STAGE(bufoff, gbase, voff) do { _Pragma("unroll") for (int _i = 0; _i < 2; ++_i) \
        __builtin_amdgcn_global_load_lds((const unsigned*)((const char*)(gbase) + (voff)[_i]), (PG8_LAS unsigned*)(lds + (bufoff) + ldsw + _i * 8192), 16, 0, 0); } while (0)
#define PG8_LDA(dst, b, h) do { _Pragma("unroll") for (int m = 0; m < 4; ++m) _Pragma("unroll") for (int k = 0; k < 2; ++k) dst[m][k] = *(const PG8_LAS bf16x8*)(lds + PG8_SA(b, h) + aoff + m * 2048 + k * 1024); } while (0)
#define PG8_LDB(dst, b, h) do { _Pragma("unroll") for (int n = 0; n < 2; ++n) _Pragma("unroll") for (int k = 0; k < 2; ++k) dst[n][k] = *(const PG8_LAS bf16x8*)(lds + PG8_SB(b, h) + boff + n * 2048 + k * 1024); } while (0)
#define PG8_MMA(ai, bj, At, Bt) do { __builtin_amdgcn_s_setprio(1); _Pragma("unroll") for (int m = 0; m < 4; ++m) _Pragma("unroll") for (int n = 0; n < 2; ++n) _Pragma("unroll") for (int k = 0; k < 2; ++k) \
        acc[ai][bj][m][n] = __builtin_amdgcn_mfma_f32_16x16x32_bf16(Bt[n][k], At[m][k], acc[ai][bj][m][n], 0, 0, 0); __builtin_amdgcn_s_setprio(0); } while (0)
#define PG8_WAIT_V(n) asm volatile("s_waitcnt vmcnt(" #n ")" ::: "memory")
#define PG8_WAIT_L(n) asm volatile("s_waitcnt lgkmcnt(" #n ")" ::: "memory")
#define PG8_BAR __builtin_amdgcn_s_barrier()
#define PG8_SCHED __builtin_amdgcn_sched_barrier(0)
    Unit cur, nxt; int ui = 0;
    if (!S.next(0, cur)) return;
    f32x4 acc[2][2][4][2];
#pragma unroll
    for (int a = 0; a < 2; ++a)
#pragma unroll
        for (int b = 0; b < 2; ++b)
#pragma unroll
            for (int m = 0; m < 4; ++m)
#pragma unroll
                for (int n = 0; n < 2; ++n) acc[a][b][m][n] = (f32x4){0.f, 0.f, 0.f, 0.f};
    bf16x8 At[4][2], B0[2][2], B1[2][2];
    const char* cA = (const char*)g.A + (size_t)cur.pa * tstepA + cur.koff; const char* cB = (const char*)g.Bt + (size_t)cur.pb * tstepB + cur.koff;
    PG8_STAGE(PG8_SB(0, 0), cB, voffB); PG8_STAGE(PG8_SB(0, 1), cB + hstepB, voffB); PG8_STAGE(PG8_SA(0, 0), cA, voffA); PG8_STAGE(PG8_SA(0, 1), cA + hstepA, voffA);
    if (wr == 1) PG8_BAR;
    PG8_WAIT_V(2); PG8_BAR;
    PG8_STAGE(PG8_SB(1, 0), cB + kstep, voffB); PG8_STAGE(PG8_SA(1, 0), cA + kstep, voffA); PG8_STAGE(PG8_SB(1, 1), cB + hstepB + kstep, voffB);
    PG8_WAIT_V(6); PG8_BAR;
    for (;;) {
        const bool has_next = S.next(ui + 1, nxt);
        const char* nA = has_next ? (const char*)g.A + (size_t)nxt.pa * tstepA + nxt.koff : cA; const char* nB = has_next ? (const char*)g.Bt + (size_t)nxt.pb * tstepB + nxt.koff : cB;
        for (int t = 0; t < nt; t += 2) {
            const bool last = (t == nt - 2);
            const char* a1 = cA + (size_t)(t + 1) * kstep;
            const char* a2 = last ? nA : cA + (size_t)(t + 2) * kstep; const char* b2 = last ? nB : cB + (size_t)(t + 2) * kstep;
            const char* a3 = a2 + kstep; const char* b3 = b2 + kstep;
            PG8_LDB(B0, 0, 0); PG8_LDB(B1, 0, 1); PG8_SCHED; PG8_LDA(At, 0, 0); PG8_STAGE(PG8_SA(1, 1), a1 + hstepA, voffA);
            PG8_WAIT_V(8); PG8_WAIT_L(0); PG8_BAR; PG8_MMA(0, 0, At, B0); PG8_MMA(0, 1, At, B1); PG8_BAR; PG8_SCHED;
            PG8_LDA(At, 0, 1); PG8_STAGE(PG8_SB(0, 0), b2, voffB); PG8_STAGE(PG8_SB(0, 1), b2 + hstepB, voffB); PG8_STAGE(PG8_SA(0, 0), a2, voffA);
            PG8_WAIT_V(8); PG8_WAIT_L(0); PG8_BAR; PG8_MMA(1, 0, At, B0); PG8_MMA(1, 1, At, B1); PG8_BAR; PG8_SCHED;
            PG8_LDB(B0, 1, 0); PG8_LDB(B1, 1, 1); PG8_SCHED; PG8_LDA(At, 1, 0); PG8_STAGE(PG8_SA(0, 1), a2 + hstepA, voffA);
            PG8_WAIT_V(8); PG8_WAIT_L(0); PG8_BAR; PG8_MMA(0, 0, At, B0); PG8_MMA(0, 1, At, B1); PG8_BAR; PG8_SCHED;
            PG8_LDA(At, 1, 1); PG8_STAGE(PG8_SB(1, 0), b3, voffB); PG8_STAGE(PG8_SB(1, 1), b3 + hstepB, voffB); PG8_STAGE(PG8_SA(1, 0), a3, voffA);
            PG8_WAIT_V(8); PG8_WAIT_L(0); PG8_BAR; PG8_MMA(1, 0, At, B0); PG8_MMA(1, 1, At, B1); PG8_BAR; PG8_SCHED;
        }
        if constexpr (ALIGN_EPI) { if (wr == 0) PG8_BAR; }
        E(acc, cur, wr, wc, fr, fq);
        if (!has_next) break;
#pragma unroll
        for (int a = 0; a < 2; ++a)
#pragma unroll
            for (int b = 0; b < 2; ++b)
#pragma unroll
                for (int m = 0; m < 4; ++m)
#pragma unroll
                    for (int n = 0; n < 2; ++n) acc[a][b][m][n] = (f32x4){0.f, 0.f, 0.f, 0.f};
        cur = nxt; cA = nA; cB = nB; ++ui;
        if constexpr (ALIGN_EPI) { if (wr == 1) PG8_BAR; }
    }
    PG8_WAIT_V(0);
    if constexpr (!ALIGN_EPI) { if (wr == 0) PG8_BAR; }
    PG8_BAR;
#undef PG8_SA
#undef PG8_SB
#undef PG8_STAGE
#undef PG8_LDA
#undef PG8_LDB
#undef PG8_MMA
#undef PG8_WAIT_V
#undef PG8_WAIT_L
#undef PG8_BAR
#undef PG8_SCHED
}
}

#ifndef PHREP
#define PHREP 0ull
#endif
#ifndef PHMASK
#define PHMASK 0xffffffffu
#endif
constexpr int SEQ = 16384, DM = 1024, CTXL = 256, NG = 32, GH = 16, NP = 64, TC = 32, NCH = SEQ / TC, NCC = CTXL / TC;
constexpr int NEXP = 32, TOPK = 4, DEXP = 1024;
constexpr float LN_EPS = 1e-5f;
constexpr float DN_ALPHA = 1.189207115002721f;
constexpr int NWAVES = 8;
constexpr int LDS_BYTES = 147456, RING_BYTES = 131072, LDSCTL_OFF = 139264, MISC_OFF = LDSCTL_OFF + 320;
constexpr int MAXTILES = 288;

constexpr size_t MiB = 1u << 20;
constexpr size_t WS_CTL = 0, CTL_ZERO_BYTES = 1 * MiB;
constexpr int CW_BAR = 4096;
constexpr size_t WS_MODP = 1 * MiB;
constexpr size_t WS_MOD  = 2 * MiB;
constexpr size_t WS_POS  = 2 * MiB + 64 * 1024;
constexpr size_t WS_TW   = 3 * MiB;
constexpr size_t WS_PCS  = 3 * MiB + 256 * 1024;
constexpr size_t WS_ECTX = 4 * MiB;
constexpr size_t WS_ZP   = 4 * MiB + 512 * 1024;
constexpr size_t WS_UCB  = 5 * MiB;
constexpr size_t WS_BIASP1 = 5 * MiB + 512 * 1024;
constexpr size_t WS_WRI  = 6 * MiB;
constexpr size_t WS_EID  = 7 * MiB;
constexpr size_t WS_GATE = 7 * MiB + 256 * 1024;
constexpr size_t WS_HIST = 7 * MiB + 512 * 1024;
constexpr size_t WS_SROW = 8 * MiB;
constexpr size_t WS_SGATE = 8 * MiB + 512 * 1024;
constexpr size_t WS_TEXP = 9 * MiB;
constexpr size_t WS_AB   = 10 * MiB;
constexpr size_t WS_BB   = 12 * MiB;
constexpr size_t WS_PCS4 = 16 * MiB;
constexpr size_t WS_KT   = 14 * MiB;
constexpr size_t WS_WGLU = 20 * MiB, WS_WBRS = 21 * MiB, WS_WBRF = 22 * MiB, WS_WOUT = 23 * MiB, WS_WDFT = 25 * MiB;
constexpr size_t WS_WUP  = 32 * MiB;
constexpr size_t WS_WDN  = 160 * MiB;
constexpr size_t WS_RES  = 224 * MiB;
constexpr size_t WS_UB   = 288 * MiB;
constexpr size_t WS_WIN  = 320 * MiB;
constexpr size_t WS_MYT  = 326 * MiB;
constexpr size_t WS_MET  = 350 * MiB;
constexpr size_t WS_ACAT = 358 * MiB;
constexpr size_t WS_A1   = 382 * MiB, WS_A2 = 398 * MiB;
constexpr size_t WS_E    = 414 * MiB;
constexpr size_t WS_GT   = 430 * MiB;
constexpr size_t WS_Y5   = 494 * MiB, WS_ZR = 510 * MiB, WS_Z5 = 526 * MiB;
constexpr size_t WS_V1   = 542 * MiB;
constexpr size_t WS_V    = 606 * MiB;
constexpr size_t WS_XS   = 320 * MiB;
constexpr size_t WS_ACT  = 464 * MiB;
constexpr size_t WS_Y2   = 608 * MiB;
constexpr size_t WS_END  = 736 * MiB;

#define LDS_WAIT() asm volatile("s_waitcnt lgkmcnt(0)" ::: "memory")
#define VM_WAIT() asm volatile("s_waitcnt vmcnt(0)" ::: "memory")
__device__ __forceinline__ unsigned f2bf(float f) { unsigned u = __builtin_bit_cast(unsigned, f); return (u + 0x7fffu + ((u >> 16) & 1u)) >> 16; }
__device__ __forceinline__ unsigned pk2(float lo, float hi) { return pg8::cvt_pk_bf16(lo, hi); }
__device__ __forceinline__ float bf2f(unsigned h) { return __builtin_bit_cast(float, h << 16); }
__device__ __forceinline__ float wave_sum(float v) {
#pragma unroll
    for (int o = 1; o < 64; o <<= 1) v += __shfl_xor(v, o);
    return v;
}
__device__ __forceinline__ float sigmoidf_(float y) { return __builtin_amdgcn_rcpf(1.0f + __builtin_amdgcn_exp2f(-1.4426950408889634f * y)); }
__device__ __forceinline__ float gelu_tanh(float x) { const float z = 0.7978845608028654f * (x + 0.044715f * x * x * x); return x * sigmoidf_(2.0f * z); }
__device__ __forceinline__ int row_of_tok(int t) { return ((t & 127) << 7) | (t >> 7); }

#define XB_TMO      128
#define XB_XCNT(j)  (256  + 64 * (j))
#define XB_XSUB(j)  (1280 + 64 * (j))
#define XB_XGEN(j)  (2304 + 64 * (j))
#define XB_TOP      3328
#define XB_TOPGEN   3392
#define XCD_BAR_WORDS 3456
#define XB_SPIN_CAP (1u << 18)
__device__ __forceinline__ unsigned xb_ld(unsigned* p)              { return __hip_atomic_load(p, __ATOMIC_RELAXED, __HIP_MEMORY_SCOPE_AGENT); }
__device__ __forceinline__ unsigned xb_add(unsigned* p, unsigned v) { return __hip_atomic_fetch_add(p, v, __ATOMIC_RELAXED, __HIP_MEMORY_SCOPE_AGENT); }
__device__ __forceinline__ unsigned xb_xcc_id() { return (unsigned)__builtin_amdgcn_s_getreg((3 << 11) | 20) & 0xFu; }
#define XB_SPIN(cond, bar) do { unsigned _sp = 0; while (cond) { __builtin_amdgcn_s_sleep(1); \
    if ((++_sp & 255u) == 0u) { if (xb_ld(&(bar)[XB_TMO])) break; if (_sp > XB_SPIN_CAP) { atomicAdd(&(bar)[XB_TMO], 1u); break; } } } } while (0)
struct XcdBarrier { unsigned* bar; unsigned x; volatile LAS unsigned* st; };
__device__ __forceinline__ XcdBarrier xcd_barrier_post(unsigned* bar, volatile LAS unsigned* st) {
    XcdBarrier b; b.bar = bar; b.x = xb_xcc_id(); b.st = st;
    if (threadIdx.x == 0) (void)xb_add(&bar[XB_XCNT(b.x)], 1u);
    return b;
}
__device__ __forceinline__ void xcd_barrier_complete(unsigned* bar, unsigned x, unsigned& nloc, unsigned& nx) {
    const unsigned G = gridDim.x * gridDim.y * gridDim.z;
    unsigned sum, cnt, mine, sp = 0u;
    for (;;) {
        sum = 0u; cnt = 0u; mine = 0u;
#pragma unroll
        for (unsigned j = 0; j < 16; ++j) { const unsigned c = xb_ld(&bar[XB_XCNT(j)]); sum += c; cnt += (c > 0u) ? 1u : 0u; mine = (j == x) ? c : mine; }
        if (sum == G) break;
        __builtin_amdgcn_s_sleep(1);
        if ((++sp & 255u) == 0u) { if (xb_ld(&bar[XB_TMO])) break; if (sp > XB_SPIN_CAP) { atomicAdd(&bar[XB_TMO], 1u); break; } }
    }
    nloc = mine > 0u ? mine : 1u; nx = cnt > 0u ? cnt : 1u;
}
__device__ __forceinline__ void xcd_barrier(const XcdBarrier& b) {
    asm volatile("s_waitcnt vmcnt(0)" ::: "memory");
    __syncthreads();
    if (threadIdx.x == 0) {
        unsigned* bar = b.bar;
        __builtin_amdgcn_s_waitcnt(0);
        unsigned nloc = b.st[0], nx = b.st[1];
        if (nloc == 0u) { xcd_barrier_complete(bar, b.x, nloc, nx); b.st[0] = nloc; b.st[1] = nx; }
        const unsigned old = xb_add(&bar[XB_XSUB(b.x)], 1u);
        const unsigned gen = old / nloc;
        if (old + 1u == (gen + 1u) * nloc) {
            __builtin_amdgcn_fence(__ATOMIC_RELEASE, "agent");
            asm volatile("s_waitcnt vmcnt(0)" ::: "memory");
            const unsigned og = xb_add(&bar[XB_TOP], 1u);
            const unsigned tg = og / nx;
            if (og + 1u == (tg + 1u) * nx) xb_add(&bar[XB_TOPGEN], 1u);
            else XB_SPIN(xb_ld(&bar[XB_TOPGEN]) == tg, bar);
            __builtin_amdgcn_fence(__ATOMIC_ACQUIRE, "agent");
            xb_add(&bar[XB_XGEN(b.x)], 1u);
            asm volatile("s_waitcnt vmcnt(0)" ::: "memory");
        } else {
            XB_SPIN(xb_ld(&bar[XB_XGEN(b.x)]) == gen, bar);
            __builtin_amdgcn_fence(__ATOMIC_ACQUIRE, "agent");
            asm volatile("s_waitcnt vmcnt(0)" ::: "memory");
        }
    }
    __syncthreads();
}

enum { I_X = 0, I_C, I_CTX, I_CCTX, I_LNING, I_LNINB, I_WADA, I_BADA, I_WIN, I_BIN, I_LAMRE, I_LAMIM, I_LOGDT, I_BRE, I_BIM, I_CRE, I_CIM, I_S5D,
       I_WGLU, I_BGLU, I_WBRS, I_WBRF, I_BBRF, I_WOUT, I_BOUT, I_LN1G, I_LN1B, I_WR, I_BR, I_WUP, I_BUP, I_WDN, I_BDN, I_LN2G, I_LN2B, N_IN };
struct Args { const float* in[N_IN]; float* out; unsigned char* ws; };

__device__ __forceinline__ void tr_issue(const float* W, int N, int k0, int n0, LAS float* scr, int lane) {
    const float* src = W + (size_t)k0 * N + n0 + lane;
#pragma unroll
    for (int kk = 0; kk < 32; ++kk) __builtin_amdgcn_global_load_lds((const unsigned*)(src + (size_t)kk * N), (LAS unsigned*)(scr + kk * 65), 4, 0, 0);
}
__device__ __forceinline__ void tr_out(bf16* WT, int K, int k0, int drow0, const LAS float* scr, int lane) {
    const int c = lane & 3, nl = lane >> 2;
#pragma unroll
    for (int j = 0; j < 4; ++j) { const int n = nl + 16 * j; const LAS float* s = scr + (8 * c) * 65 + n;
        v4u o; o.x = pg8::cvt_pk_bf16(s[0 * 65], s[1 * 65]); o.y = pg8::cvt_pk_bf16(s[2 * 65], s[3 * 65]); o.z = pg8::cvt_pk_bf16(s[4 * 65], s[5 * 65]); o.w = pg8::cvt_pk_bf16(s[6 * 65], s[7 * 65]);
        *(GAS v4u*)(WT + (size_t)(drow0 + n) * K + k0 + 8 * c) = o; }
    LDS_WAIT(); asm volatile("" ::: "memory");
}
struct TrItem { const float* W; bf16* WT; int K, N, k0, n0, drow0; };
__device__ __forceinline__ int paired_row(int n, int HN) { return n < HN ? ((n >> 7) << 8) + (n & 127) : (((n - HN) >> 7) << 8) + 128 + ((n - HN) & 127); }

using pg8::Unit; using pg8::cvt_pk_bf16;
#define EPI_ARGS const f32x4 (&acc)[2][2][4][2], const Unit& u, int wr, int wc, int fr, int fq

struct EpiP1 {
    static constexpr bool PERM = true;
    const float* bias; bf16* acat; bf16* a1; bf16* gt;
    __device__ __forceinline__ void operator()(EPI_ARGS) const {
        const int row0 = u.pm * 256 + wr * 64 + fr;
#pragma unroll
        for (int bj = 0; bj < 2; ++bj) {
            const int c0 = u.pn * 256 + bj * 128 + wc * 32 + 8 * fq;
            const f32x4 b0 = *(const f32x4*)(bias + c0), b1 = *(const f32x4*)(bias + c0 + 4);
#pragma unroll
            for (int ai = 0; ai < 2; ++ai)
#pragma unroll
                for (int m = 0; m < 4; ++m) {
                    const int r = row0 + ai * 128 + m * 16;
                    f32x4 v0 = acc[ai][bj][m][0] + b0, v1 = acc[ai][bj][m][1] + b1;
                    if (u.pn < 2) {
                        const int t = row_of_tok(r), ci = t >> 5, tau = t & 31, g = c0 >> 4, h0 = c0 & 15;
                        v4u w; w.x = cvt_pk_bf16(v0[0], v0[1]); w.y = cvt_pk_bf16(v0[2], v0[3]); w.z = cvt_pk_bf16(v1[0], v1[1]); w.w = cvt_pk_bf16(v1[2], v1[3]);
                        *(v4u*)(acat + ((size_t)(g * NCH + ci) * 768 + tau * 16 + h0)) = w;
                    } else if (u.pn < 4) {
                        const int cc = c0 - 512, g = cc >> 7, j0 = (cc & 127) >> 1, n2 = r >> 7, n1 = r & 127;
                        const unsigned w[4] = {cvt_pk_bf16(v0[0], v0[1]), cvt_pk_bf16(v0[2], v0[3]), cvt_pk_bf16(v1[0], v1[1]), cvt_pk_bf16(v1[2], v1[3])};
#pragma unroll
                        for (int q = 0; q < 4; ++q) { const int colc = g * 64 + j0 + q, rho1 = (colc >> 1) * 256 + (colc & 1) * 128 + n2;
                            *(unsigned*)(a1 + ((size_t)rho1 * 256 + 2 * n1)) = w[q]; }
                    } else {
                        v4u w; w.x = cvt_pk_bf16(sigmoidf_(v0[0]), sigmoidf_(v0[1])); w.y = cvt_pk_bf16(sigmoidf_(v0[2]), sigmoidf_(v0[3]));
                        w.z = cvt_pk_bf16(sigmoidf_(v1[0]), sigmoidf_(v1[1])); w.w = cvt_pk_bf16(sigmoidf_(v1[2]), sigmoidf_(v1[3]));
#ifdef DBG_CONSTGT
                        w = (v4u){0x3f803f80u, 0x3f803f80u, 0x3f803f80u, 0x3f803f80u};
#endif
#ifdef DBG_RAWGT
                        w.x = cvt_pk_bf16(v0[0], v0[1]); w.y = cvt_pk_bf16(v0[2], v0[3]); w.z = cvt_pk_bf16(v1[0], v1[1]); w.w = cvt_pk_bf16(v1[2], v1[3]);
#endif
                        *(v4u*)(gt + ((size_t)r * 2048 + (c0 - 1024))) = w;
                    }
                }
        }
    }
};
struct EpiF1 {
    static constexpr bool PERM = true;
    const float* tw; bf16* a2;
    __device__ __forceinline__ void operator()(EPI_ARGS) const {
#pragma unroll
        for (int ai = 0; ai < 2; ++ai)
#pragma unroll
            for (int m = 0; m < 4; ++m) {
                const unsigned rho1 = u.pa * 256 + ai * 128 + wr * 64 + m * 16 + fr, colc = rho1 >> 7, n2 = rho1 & 127;
#pragma unroll
                for (int bj = 0; bj < 2; ++bj) {
                    const unsigned m10 = (bj * 128 + wc * 32 + 8 * fq) >> 1;
                    const f32x4 t0 = *(const f32x4*)(tw + (n2 * 128u + m10) * 2u), t1 = *(const f32x4*)(tw + (n2 * 128u + m10 + 2u) * 2u);
                    const f32x4 v0 = acc[ai][bj][m][0], v1 = acc[ai][bj][m][1];
                    const unsigned o0 = (m10 * 256u + colc) * 256u + 2u * n2;
                    *(unsigned*)(a2 + o0)             = cvt_pk_bf16(v0[0] * t0[0] - v0[1] * t0[1], v0[0] * t0[1] + v0[1] * t0[0]);
                    *(unsigned*)(a2 + o0 + 65536u)    = cvt_pk_bf16(v0[2] * t0[2] - v0[3] * t0[3], v0[2] * t0[3] + v0[3] * t0[2]);
                    *(unsigned*)(a2 + o0 + 2u * 65536u) = cvt_pk_bf16(v1[0] * t1[0] - v1[1] * t1[1], v1[0] * t1[1] + v1[1] * t1[0]);
                    *(unsigned*)(a2 + o0 + 3u * 65536u) = cvt_pk_bf16(v1[2] * t1[2] - v1[3] * t1[3], v1[2] * t1[3] + v1[3] * t1[2]);
                }
                asm volatile("" ::: "memory");
            }
    }
};
struct EpiF2 {
    static constexpr bool PERM = true;
    bf16* zr; float* zp;
    __device__ __forceinline__ void operator()(EPI_ARGS) const {
        const unsigned m1 = u.pa, m1p = m1 > 0 ? 128 - m1 : 0;
#pragma unroll
        for (int ai = 0; ai < 2; ++ai)
#pragma unroll
            for (int m = 0; m < 4; ++m) {
                const unsigned colc = ai * 128 + wr * 64 + m * 16 + fr, g = colc >> 6, j = colc & 63;
#pragma unroll
                for (int bj = 0; bj < 2; ++bj) {
                    const unsigned m20 = bj * 64 + wc * 16 + 4 * fq;
                    const f32x4 v0 = acc[ai][bj][m][0], v1 = acc[ai][bj][m][1];
                    const float re[4] = {v0[0], v0[2], v1[0], v1[2]}, im[4] = {v0[1], v0[3], v1[1], v1[3]};
                    const unsigned o0 = (m1 * 128u + m20) * 512u + g * 128u + j;
                    if (j >= 1) {
#pragma unroll
                        for (int q = 0; q < 4; ++q) { const unsigned m2 = m20 + q, m2p = m1 > 0 ? 127u - m2 : ((128u - m2) & 127u); const bf16 h = (bf16)f2bf(re[q]);
                            zr[o0 + q * 512u] = h; zr[(m1p * 128u + m2p) * 512u + g * 128u + 128u - j] = h; }
                    } else {
#pragma unroll
                        for (int q = 0; q < 4; ++q) *(f32x2*)(zp + ((m1 * 128u + m20 + q) * 4u + g) * 2u) = (f32x2){re[q], im[q]};
                    }
                }
                asm volatile("" ::: "memory");
            }
    }
};
struct EpiE {
    static constexpr bool PERM = false;
    float* e;
    __device__ __forceinline__ void operator()(EPI_ARGS) const {
#pragma unroll
        for (int ai = 0; ai < 2; ++ai)
#pragma unroll
            for (int m = 0; m < 4; ++m) { float* rowp = e + (size_t)(u.pa * 256 + ai * 128 + wr * 64 + m * 16 + fr) * 256 + wc * 32 + 4 * fq;
#pragma unroll
                for (int bj = 0; bj < 2; ++bj)
#pragma unroll
                    for (int n = 0; n < 2; ++n) *(f32x4*)(rowp + bj * 128 + n * 16) = acc[ai][bj][m][n]; }
    }
};
struct EpiPcs {
    static constexpr bool PERM = false;
    float* pcs;
    __device__ __forceinline__ void operator()(EPI_ARGS) const {
        const int col0 = u.pn * 256 + wc * 32 + 4 * fq;
#pragma unroll
        for (int ai = 0; ai < 2; ++ai)
#pragma unroll
            for (int m = 0; m < 4; ++m) { float* rowp = pcs + (size_t)u.aux * 131072 + (size_t)(ai * 128 + wr * 64 + m * 16 + fr) * 512 + col0;
#pragma unroll
                for (int bj = 0; bj < 2; ++bj)
#pragma unroll
                    for (int n = 0; n < 2; ++n) *(f32x4*)(rowp + bj * 128 + n * 16) = acc[ai][bj][m][n]; }
    }
};
struct EpiY5 {
    static constexpr bool PERM = true;
    bf16* y5;
    __device__ __forceinline__ void operator()(EPI_ARGS) const {
        const int g = u.aux;
#pragma unroll
        for (int ai = 0; ai < 2; ++ai)
#pragma unroll
            for (int m = 0; m < 4; ++m) {
                const int c = u.pm * 256 + ai * 128 + wr * 64 + m * 16 + fr;
#pragma unroll
                for (int bj = 0; bj < 2; ++bj) {
                    const int n_ = u.pn * 256 + bj * 128 + wc * 32 + 8 * fq, tau = n_ >> 4, h0 = n_ & 15, r = row_of_tok(32 * c + tau);
                    const f32x4 v0 = acc[ai][bj][m][0], v1 = acc[ai][bj][m][1];
                    v4u w; w.x = cvt_pk_bf16(gelu_tanh(v0[0]), gelu_tanh(v0[1])); w.y = cvt_pk_bf16(gelu_tanh(v0[2]), gelu_tanh(v0[3]));
                    w.z = cvt_pk_bf16(gelu_tanh(v1[0]), gelu_tanh(v1[1])); w.w = cvt_pk_bf16(gelu_tanh(v1[2]), gelu_tanh(v1[3]));
                    *(v4u*)(y5 + ((size_t)r * 512 + g * 16 + h0)) = w;
                }
            }
    }
};
template <int MODE> struct EpiPair {
    static constexpr bool PERM = true;
    bf16* o; int ldo; const float* bias; int hn;
    __device__ __forceinline__ void operator()(EPI_ARGS) const {
        const float* bb = bias + (MODE == 1 ? (size_t)u.aux * 2 * hn : 0);
        const int cl = u.pn * 128 + wc * 32 + 8 * fq;
        const f32x4 ba0 = *(const f32x4*)(bb + cl), ba1 = *(const f32x4*)(bb + cl + 4), bb0 = *(const f32x4*)(bb + hn + cl), bb1 = *(const f32x4*)(bb + hn + cl + 4);
#pragma unroll
        for (int ai = 0; ai < 2; ++ai)
#pragma unroll
            for (int m = 0; m < 4; ++m) {
                const int r = u.pm * 256 + ai * 128 + wr * 64 + m * 16 + fr;
                const f32x4 a0 = acc[ai][0][m][0] + ba0, a1 = acc[ai][0][m][1] + ba1, g0 = acc[ai][1][m][0] + bb0, g1 = acc[ai][1][m][1] + bb1;
                float o8[8];
#pragma unroll
                for (int i = 0; i < 4; ++i) {
                    if (MODE == 0) { o8[i] = a0[i] * sigmoidf_(g0[i]); o8[4 + i] = a1[i] * sigmoidf_(g1[i]); }
                    else { const float x0 = fminf(a0[i], 7.0f), x1 = fminf(a1[i], 7.0f), l0 = fminf(fmaxf(g0[i], -7.0f), 7.0f), l1 = fminf(fmaxf(g1[i], -7.0f), 7.0f);
                        o8[i] = x0 * sigmoidf_(1.702f * x0) * (l0 + 1.0f); o8[4 + i] = x1 * sigmoidf_(1.702f * x1) * (l1 + 1.0f); }
                }
                v4u w; w.x = cvt_pk_bf16(o8[0], o8[1]); w.y = cvt_pk_bf16(o8[2], o8[3]); w.z = cvt_pk_bf16(o8[4], o8[5]); w.w = cvt_pk_bf16(o8[6], o8[7]);
                *(v4u*)(o + ((size_t)r * ldo + cl)) = w;
            }
    }
};
struct EpiV1 {
    static constexpr bool PERM = true;
    float* v1; const bf16* gt;
    __device__ __forceinline__ void operator()(EPI_ARGS) const {
#pragma unroll
        for (int ai = 0; ai < 2; ++ai)
#pragma unroll
            for (int m = 0; m < 4; ++m) {
                const int r = u.pm * 256 + ai * 128 + wr * 64 + m * 16 + fr;
#pragma unroll
                for (int bj = 0; bj < 2; ++bj) {
                    const int c0 = u.pn * 256 + bj * 128 + wc * 32 + 8 * fq;
                    const v4u gw = *(const v4u*)(gt + ((size_t)r * 2048 + c0));
                    const f32x4 v0 = acc[ai][bj][m][0], v1_ = acc[ai][bj][m][1];
                    f32x4 o0, o1;
                    o0[0] = v0[0] * bf2f(gw.x & 0xffffu); o0[1] = v0[1] * bf2f(gw.x >> 16); o0[2] = v0[2] * bf2f(gw.y & 0xffffu); o0[3] = v0[3] * bf2f(gw.y >> 16);
                    o1[0] = v1_[0] * bf2f(gw.z & 0xffffu); o1[1] = v1_[1] * bf2f(gw.z >> 16); o1[2] = v1_[2] * bf2f(gw.w & 0xffffu); o1[3] = v1_[3] * bf2f(gw.w >> 16);
                    float* p = v1 + ((size_t)r * 1024 + c0);
                    *(f32x4*)p = o0; *(f32x4*)(p + 4) = o1;
                }
            }
    }
};
struct EpiV {
    static constexpr bool PERM = true;
    const float* v1; const bf16* gt; const float* bias; bf16* v;
    __device__ __forceinline__ void operator()(EPI_ARGS) const {
#pragma unroll
        for (int bj = 0; bj < 2; ++bj) {
            const int c0 = u.pn * 256 + bj * 128 + wc * 32 + 8 * fq;
            const f32x4 b0 = *(const f32x4*)(bias + c0), b1 = *(const f32x4*)(bias + c0 + 4);
#pragma unroll
            for (int ai = 0; ai < 2; ++ai)
#pragma unroll
                for (int m = 0; m < 4; ++m) {
                    const int r = u.pm * 256 + ai * 128 + wr * 64 + m * 16 + fr;
                    const v4u gw = *(const v4u*)(gt + ((size_t)r * 2048 + 1024 + c0));
                    const float* p = v1 + ((size_t)r * 1024 + c0);
                    const f32x4 p0 = *(const f32x4*)p, p1 = *(const f32x4*)(p + 4);
                    const f32x4 v0 = acc[ai][bj][m][0] + b0, v1_ = acc[ai][bj][m][1] + b1;
                    float o[8];
                    o[0] = p0[0] + v0[0] * bf2f(gw.x & 0xffffu); o[1] = p0[1] + v0[1] * bf2f(gw.x >> 16); o[2] = p0[2] + v0[2] * bf2f(gw.y & 0xffffu); o[3] = p0[3] + v0[3] * bf2f(gw.y >> 16);
                    o[4] = p1[0] + v1_[0] * bf2f(gw.z & 0xffffu); o[5] = p1[1] + v1_[1] * bf2f(gw.z >> 16); o[6] = p1[2] + v1_[2] * bf2f(gw.w & 0xffffu); o[7] = p1[3] + v1_[3] * bf2f(gw.w >> 16);
                    v4u w; w.x = cvt_pk_bf16(o[0], o[1]); w.y = cvt_pk_bf16(o[2], o[3]); w.z = cvt_pk_bf16(o[4], o[5]); w.w = cvt_pk_bf16(o[6], o[7]);
                    *(v4u*)(v + ((size_t)r * 1024 + c0)) = w;
                }
        }
    }
};
struct EpiRes {
    static constexpr bool PERM = false;
    const float* res; float* rout; const float* bias; const float* g1;
    __device__ __forceinline__ void operator()(EPI_ARGS) const {
        const int col0 = u.pn * 256 + wc * 32 + 4 * fq;
#pragma unroll
        for (int bj = 0; bj < 2; ++bj)
#pragma unroll
            for (int n = 0; n < 2; ++n) {
                const f32x4 bv = *(const f32x4*)(bias + col0 + bj * 128 + n * 16), gv = *(const f32x4*)(g1 + col0 + bj * 128 + n * 16);
#pragma unroll
                for (int ai = 0; ai < 2; ++ai)
#pragma unroll
                    for (int m = 0; m < 4; ++m) { const size_t o = (size_t)(u.pm * 256 + ai * 128 + wr * 64 + m * 16 + fr) * 1024 + col0 + bj * 128 + n * 16;
                        const f32x4 h = *(const f32x4*)(res + o); *(f32x4*)(rout + o) = h * DN_ALPHA + gv * (acc[ai][bj][m][n] + bv); }
            }
    }
};
struct EpiDown {
    static constexpr bool PERM = true;
    bf16* y2; const float* bias; const int* srow; const float* sgate;
    __device__ __forceinline__ void operator()(EPI_ARGS) const {
        const float* bb = bias + (size_t)u.aux * 1024;
#pragma unroll
        for (int ai = 0; ai < 2; ++ai)
#pragma unroll
            for (int m = 0; m < 4; ++m) {
                const int d = u.pm * 256 + ai * 128 + wr * 64 + m * 16 + fr, sr = srow[d]; const float gs = sgate[d];
                if (sr >= 0) {
#pragma unroll
                    for (int bj = 0; bj < 2; ++bj) {
                        const int c0 = u.pn * 256 + bj * 128 + wc * 32 + 8 * fq;
                        const f32x4 v0 = (acc[ai][bj][m][0] + *(const f32x4*)(bb + c0)) * gs, v1 = (acc[ai][bj][m][1] + *(const f32x4*)(bb + c0 + 4)) * gs;
                        v4u w; w.x = cvt_pk_bf16(v0[0], v0[1]); w.y = cvt_pk_bf16(v0[2], v0[3]); w.z = cvt_pk_bf16(v1[0], v1[1]); w.w = cvt_pk_bf16(v1[2], v1[3]);
                        *(v4u*)(y2 + ((size_t)sr * 1024 + c0)) = w;
                    }
                }
            }
    }
};

__global__ void __launch_bounds__(NWAVES * 64, 2) mk_fwd(Args args) {
    extern __shared__ __attribute__((aligned(16))) unsigned char lds_raw[];
    LAS unsigned char* lds = (LAS unsigned char*)lds_raw;
    volatile LAS unsigned* MISC = (volatile LAS unsigned*)(lds + MISC_OFF);
    {
        const int tid0 = threadIdx.x;
        for (int u = tid0; u < (LDS_BYTES - LDSCTL_OFF) / 4; u += NWAVES * 64) ((LAS unsigned*)(lds + LDSCTL_OFF))[u] = 0u;
    }
    __syncthreads();
    XcdBarrier bar = xcd_barrier_post((unsigned*)(args.ws + WS_CTL) + CW_BAR, MISC + 8);
#define GRID_BAR() xcd_barrier(bar)
    typedef __attribute__((address_space(4))) const unsigned long long karg_t;
#define INP(i) ((const float*)KA[i])
#define PH_BEGIN() int tid = threadIdx.x; asm volatile("" : "+v"(tid)); const int lane = tid & 63, wave = __builtin_amdgcn_readfirstlane(tid >> 6); \
    int G = gridDim.x, b = blockIdx.x; asm volatile("" : "+s"(G), "+s"(b)); karg_t* KA = (karg_t*)__builtin_amdgcn_kernarg_segment_ptr(); asm volatile("" : "+s"(KA)); unsigned char* ws = (unsigned char*)KA[N_IN + 1]; \
    const int gw = b * NWAVES + wave, NGW = G * NWAVES, gt_ = b * (NWAVES * 64) + tid, NGT = G * NWAVES * 64; (void)lane; (void)gw; (void)NGW; (void)gt_; (void)NGT; (void)ws
#define MODP ((float*)(ws + WS_MODP))
#define MOD ((float*)(ws + WS_MOD))
#define POS ((float*)(ws + WS_POS))
#define TW ((float*)(ws + WS_TW))
#define PCS ((float*)(ws + WS_PCS))
#define ECTX ((float*)(ws + WS_ECTX))
#define UCB ((bf16*)(ws + WS_UCB))
#define PCS4 ((float*)(ws + WS_PCS4))
#define ZP ((float*)(ws + WS_ZP))
#define BIASP1 ((float*)(ws + WS_BIASP1))
#define WRI ((float*)(ws + WS_WRI))
#define EID ((int*)(ws + WS_EID))
#define GATE ((float*)(ws + WS_GATE))
#define HIST ((int*)(ws + WS_HIST))
#define SROW ((int*)(ws + WS_SROW))
#define SGATE ((float*)(ws + WS_SGATE))
#define TEXP ((int*)(ws + WS_TEXP))
#define AB ((float*)(ws + WS_AB))
#define BB ((float*)(ws + WS_BB))
#define KT ((float*)(ws + WS_KT))
#define WGLU ((bf16*)(ws + WS_WGLU))
#define WBRS ((bf16*)(ws + WS_WBRS))
#define WBRF ((bf16*)(ws + WS_WBRF))
#define WOUT ((bf16*)(ws + WS_WOUT))
#define WDFT ((bf16*)(ws + WS_WDFT))
#define WUP ((bf16*)(ws + WS_WUP))
#define WDN ((bf16*)(ws + WS_WDN))
#define RES ((float*)(ws + WS_RES))
#define UB ((bf16*)(ws + WS_UB))
#define WIN ((bf16*)(ws + WS_WIN))
#define MYT ((bf16*)(ws + WS_MYT))
#define MET ((bf16*)(ws + WS_MET))
#define ACAT ((bf16*)(ws + WS_ACAT))
#define A1 ((bf16*)(ws + WS_A1))
#define A2 ((bf16*)(ws + WS_A2))
#define EBUF ((float*)(ws + WS_E))
#define GT ((bf16*)(ws + WS_GT))
#define Y5 ((bf16*)(ws + WS_Y5))
#define ZR ((bf16*)(ws + WS_ZR))
#define Z5 ((bf16*)(ws + WS_Z5))
#define V1 ((float*)(ws + WS_V1))
#define VB ((bf16*)(ws + WS_V))
#define XS ((bf16*)(ws + WS_XS))
#define ACT ((bf16*)(ws + WS_ACT))
#define Y2 ((bf16*)(ws + WS_Y2))


#ifndef DBG_STOP
#define DBG_STOP -1
#endif
#ifndef DBG_SUB
#define DBG_SUB 0
#endif
#define DBG_DUMP(n) do { if (DBG_STOP == (n)) { PH_BEGIN(); float* o_ = ((float*)KA[N_IN]); \
        for (size_t i_ = (size_t)gt_; i_ < (size_t)SEQ * DM; i_ += (size_t)NGT) { float v_ = 0.f; \
            if ((n) == 0) v_ = bf2f(WIN[i_ % (size_t)(3072 * 1024)]) + bf2f(WUP[i_ * 4]) + bf2f(WDN[i_ * 2]) + MODP[i_ % 196608] + POS[i_ & 131071] + AB[i_ % 270336] + BB[i_ & 131071] + TW[i_ & 32767] + bf2f(WDFT[i_ & 65535]) + bf2f(WGLU[i_ & 524287]) + bf2f(WOUT[i_ & 1048575]) + WRI[i_ & 32767] + BIASP1[i_ % 3072]; \
            if ((n) == 1) v_ = RES[i_] + bf2f(UB[i_]) + KT[i_ & 524287]; \
            if ((n) == 2) v_ = DBG_SUB == 0 ? bf2f(GT[i_]) + bf2f(GT[i_ + (size_t)SEQ * DM]) : DBG_SUB == 1 ? bf2f(ACAT[(i_ & 16383) * 768 + ((i_ >> 14) & 511)]) : DBG_SUB == 2 ? bf2f(A1[i_ & 8388607]) : DBG_SUB == 4 ? bf2f(WIN[i_ % (size_t)(3072 * 1024)]) + BIASP1[i_ % 3072] : DBG_SUB == 5 ? bf2f(UB[i_]) : bf2f(MYT[i_ % (size_t)(NG * 512 * 768)]) + bf2f(MET[i_ & 4194303]); \
            if ((n) == 3) v_ = bf2f(A2[i_ & 8388607]) + EBUF[i_ & 4194303] + PCS4[i_ & 524287]; \
            if ((n) == 4) v_ = bf2f(ZR[i_ & 8388607]) + bf2f(ACAT[i_ % (size_t)(NG * NCH * 768)]); \
            if ((n) == 5) v_ = bf2f(ZR[i_ & 8388607]) + bf2f(Y5[i_ & 8388607]); \
            if ((n) == 6) v_ = bf2f(Z5[i_ & 8388607]); \
            if ((n) == 7) v_ = bf2f(VB[i_]); \
            if ((n) == 8 || (n) == 9) v_ = RES[i_] + ((n) == 9 ? bf2f(UB[i_]) + GATE[i_ & 65535] : 0.f); \
            if ((n) == 10) v_ = bf2f(XS[i_]) + SGATE[i_ & 65535] + (float)SROW[i_ & 65535] * 1e-3f; \
            if ((n) == 11) v_ = bf2f(ACT[i_]); \
            if ((n) == 12) v_ = bf2f(Y2[i_]) + bf2f(Y2[i_ + (size_t)SEQ * DM]) + bf2f(Y2[i_ + 2 * (size_t)SEQ * DM]) + bf2f(Y2[i_ + 3 * (size_t)SEQ * DM]); \
            o_[i_] = v_; } return; } } while (0)

    if (PHMASK & (1u << 0))    { PH_BEGIN();
        for (int it = b; it < 256; it += G) {
            const int kc = it & 15, nc = it >> 4;
            if (tid < 384) {
                const int n = nc * 384 + tid; float a0 = 0.f, a1 = 0.f;
                const float* w = INP(I_WADA) + (size_t)(kc * 64) * 6144 + n;
                for (int k = 0; k < 64; ++k) { const float cv = INP(I_C)[kc * 64 + k], cc = INP(I_CCTX)[kc * 64 + k]; const float wv = w[(size_t)k * 6144];
                    a0 += cv * sigmoidf_(cv) * wv; a1 += cc * sigmoidf_(cc) * wv; }
                MODP[(kc * 2 + 0) * 6144 + n] = a0; MODP[(kc * 2 + 1) * 6144 + n] = a1;
            }
        }
        for (int it = gt_; it < 256 * 256; it += NGT) {
            const int p = it >> 8, i = it & 255;
            const float om = (float)(1.0 / pow(10000.0, (double)i / 256.0)); const float ang = (float)p * om;
            POS[p * 512 + i] = (float)sin((double)ang); POS[p * 512 + 256 + i] = (float)cos((double)ang);
        }
        for (int it = gt_; it < 2 * NG * NP; it += NGT) {
            const int gd = it >> 6, p = it & 63;
            const double lr = INP(I_LAMRE)[it], li = INP(I_LAMIM)[it], dt = exp((double)INP(I_LOGDT)[gd]);
            for (int k = 0; k <= 32; ++k) { const double mg = exp(lr * dt * k), an = li * dt * k; AB[((size_t)it * 33 + k) * 2] = (float)(mg * cos(an)); AB[((size_t)it * 33 + k) * 2 + 1] = (float)(mg * sin(an)); }
            const double are = exp(lr * dt) * cos(li * dt), aim = exp(lr * dt) * sin(li * dt), den = lr * lr + li * li, nr = are - 1.0;
            const double kre = (nr * lr + aim * li) / den, kim = (aim * lr - nr * li) / den;
            for (int h = 0; h < 16; ++h) { const double br = INP(I_BRE)[(size_t)it * 16 + h], bi = INP(I_BIM)[(size_t)it * 16 + h];
                BB[((size_t)it * 16 + h) * 2] = (float)(kre * br - kim * bi); BB[((size_t)it * 16 + h) * 2 + 1] = (float)(kre * bi + kim * br); }
        }
        for (int it = gt_; it < 128 * 128; it += NGT) { const int n2 = it >> 7, m1 = it & 127; const double a = -2.0 * (double)((m1 * n2) & 16383) / 16384.0;
            TW[it * 2] = (float)cospi(a); TW[it * 2 + 1] = (float)sinpi(a); }
        for (int it = gt_; it < 128 * 128; it += NGT) { const int m = it >> 7, n = it & 127; const double a = 2.0 * (double)((m * n) & 127) / 128.0, s = 0.08838834764831845;
            const float c = (float)(cospi(a) * s), sn = (float)(sinpi(a) * s);
            WDFT[(2 * m) * 256 + 2 * n] = (bf16)f2bf(c); WDFT[(2 * m) * 256 + 2 * n + 1] = (bf16)f2bf(sn); WDFT[(2 * m + 1) * 256 + 2 * n] = (bf16)f2bf(-sn); WDFT[(2 * m + 1) * 256 + 2 * n + 1] = (bf16)f2bf(c); }
        for (int it = gt_; it < 1024 * 32; it += NGT) { const int k = it >> 5, e = it & 31; WRI[((k >> 2) * 32 + e) * 4 + (k & 3)] = INP(I_WR)[it]; }
        for (int it = gt_; it < 3072; it += NGT) if (it < 512 || it >= 1024) BIASP1[it] = INP(I_BIN)[it];
        {
            LAS float* scr0 = (LAS float*)(lds + wave * 16640); LAS float* scr1 = scr0 + 32 * 65;
            constexpr int I_IN = 32 * 40, I_GLU = 16 * 16, I_BRS = 16 * 16, I_BRF = 16 * 16, I_OUT = 32 * 16, I_UP1 = 32 * 32, I_DN1 = 32 * 16;
            constexpr int NIT = I_IN + I_GLU + I_BRS + I_BRF + I_OUT + NEXP * (I_UP1 + I_DN1);
#define TR_DECODE(item, T) do { int r = (item); \
                if (r < I_IN) { const int kb = r / 40, nb = r % 40, n0 = nb < 8 ? 64 * nb : 1024 + 64 * (nb - 8); T = TrItem{INP(I_WIN), WIN, 1024, 3072, 32 * kb, n0, n0}; break; } r -= I_IN; \
                if (r < I_GLU) { const int kb = r / 16, nb = r % 16; T = TrItem{INP(I_WGLU), WGLU, 512, 1024, 32 * kb, 64 * nb, paired_row(64 * nb, 512)}; break; } r -= I_GLU; \
                if (r < I_BRS) { const int kb = r / 16, nb = r % 16; T = TrItem{INP(I_WBRS), WBRS, 512, 1024, 32 * kb, 64 * nb, 64 * nb}; break; } r -= I_BRS; \
                if (r < I_BRF) { const int kb = r / 16, nb = r % 16; T = TrItem{INP(I_WBRF), WBRF, 512, 1024, 32 * kb, 64 * nb, 64 * nb}; break; } r -= I_BRF; \
                if (r < I_OUT) { const int kb = r / 16, nb = r % 16; T = TrItem{INP(I_WOUT), WOUT, 1024, 1024, 32 * kb, 64 * nb, 64 * nb}; break; } r -= I_OUT; \
                if (r < NEXP * I_UP1) { const int e = r / I_UP1, q = r % I_UP1, kb = q / 32, nb = q % 32; \
                    T = TrItem{INP(I_WUP) + (size_t)e * 1024 * 2048, WUP + (size_t)e * 2048 * 1024, 1024, 2048, 32 * kb, 64 * nb, paired_row(64 * nb, 1024)}; break; } r -= NEXP * I_UP1; \
                { const int e = r / I_DN1, q = r % I_DN1, kb = q / 16, nb = q % 16; \
                    T = TrItem{INP(I_WDN) + (size_t)e * 1024 * 1024, WDN + (size_t)e * 1024 * 1024, 1024, 1024, 32 * kb, 64 * nb, 64 * nb}; } } while (0)
            int it = gw; TrItem T;
            if (it < NIT) { TR_DECODE(it, T); tr_issue(T.W, T.N, T.k0, T.n0, scr0, lane); }
            for (int par = 0; it < NIT; par ^= 1) {
                const int nx = it + NGW; TrItem Tn = T;
                LAS float* sc = par ? scr1 : scr0; LAS float* sn = par ? scr0 : scr1;
                if (nx < NIT) { TR_DECODE(nx, Tn); tr_issue(Tn.W, Tn.N, Tn.k0, Tn.n0, sn, lane); asm volatile("s_waitcnt vmcnt(32)" ::: "memory"); }
                else asm volatile("s_waitcnt vmcnt(0)" ::: "memory");
                tr_out(T.WT, T.K, T.k0, T.drow0, sc, lane);
                T = Tn; it = nx;
            }
#undef TR_DECODE
        }
        __syncthreads();
        {
            LAS float* fc = (LAS float*)lds;
            LAS float* wrow = (LAS float*)(lds + 65536);
            bool have_fc = false;
            for (int it = b; it < 129; it += G) {
                if (!have_fc) {
                    for (int q = tid; q < 128 * 128; q += NWAVES * 64) { const int c = q >> 7, jj = q & 127, j = jj >> 1, part = jj & 1; const double s = 0.08838834764831845; double v;
                        if (j == 0) v = part ? ((c & 1) ? -s : s) : s; else { const double a = 2.0 * (double)((j * c) & 127) / 128.0; v = part ? -sinpi(a) * s : cospi(a) * s; }
                        fc[q] = (float)v; }
                    have_fc = true;
                }
                __syncthreads();
                for (int q = tid; q < 8 * 512; q += NWAVES * 64) { const int kk = q >> 9, n = q & 511; wrow[q] = it < 128 ? INP(I_WIN)[(size_t)(it * 8 + kk) * 3072 + 512 + n] : (kk == 0 ? INP(I_BIN)[512 + n] : 0.f); }
                __syncthreads();
                const int g = tid >> 7, jj = tid & 127; float a8[8];
#pragma unroll
                for (int kk = 0; kk < 8; ++kk) a8[kk] = 0.f;
                for (int c = 0; c < 128; ++c) { const float f = fc[c * 128 + jj];
#pragma unroll
                    for (int kk = 0; kk < 8; ++kk) a8[kk] += wrow[kk * 512 + g * 128 + c] * f; }
                if (it < 128) { v4u o; o.x = pk2(a8[0], a8[1]); o.y = pk2(a8[2], a8[3]); o.z = pk2(a8[4], a8[5]); o.w = pk2(a8[6], a8[7]);
                    *(v4u*)(WIN + ((size_t)(512 + tid) * 1024 + it * 8)) = o; }
                else BIASP1[512 + tid] = a8[0];
                __syncthreads();
            }
        }
    }
    GRID_BAR();
    DBG_DUMP(0);

    if (PHMASK & (1u << 1))    { PH_BEGIN();
        LAS float* sm = (LAS float*)lds;
        for (int q = tid; q < 4096; q += NWAVES * 64) { const int v = q >> 11, n = q & 2047; float s = INP(I_BADA)[n];
            for (int kc = 0; kc < 16; ++kc) s += MODP[(kc * 2 + v) * 6144 + n];
            sm[q] = s; }
        for (int q = gt_; q < 2 * 6144; q += NGT) { const int v = q / 6144, n = q % 6144; float s = INP(I_BADA)[n];
            for (int kc = 0; kc < 16; ++kc) s += MODP[(kc * 2 + v) * 6144 + n];
            MOD[q] = s; }
        __syncthreads();
        for (int t = gw; t < SEQ; t += NGW) {
            const int rp = t >> 6, cp = t & 63, row = row_of_tok(t);
            const f32x4* xr = (const f32x4*)(INP(I_X) + (size_t)t * 1024) + lane;
            f32x4 v[4]; float s = 0.f;
#pragma unroll
            for (int j = 0; j < 4; ++j) { const int e0 = 256 * j + 4 * lane; const f32x4 pe = *(const f32x4*)(POS + (j < 2 ? rp * 512 + e0 : cp * 512 + e0 - 512));
                v[j] = xr[64 * j] + pe; s += (v[j][0] + v[j][1]) + (v[j][2] + v[j][3]); }
            const float mean = wave_sum(s) * (1.f / 1024.f); float s2 = 0.f;
#pragma unroll
            for (int j = 0; j < 4; ++j) { v[j] = v[j] - mean; s2 += (v[j][0] * v[j][0] + v[j][1] * v[j][1]) + (v[j][2] * v[j][2] + v[j][3] * v[j][3]); }
            const float rstd = 1.f / sqrtf(wave_sum(s2) * (1.f / 1024.f) + LN_EPS);
#pragma unroll
            for (int j = 0; j < 4; ++j) { const int e0 = 256 * j + 4 * lane;
                const f32x4 gg = *(const f32x4*)(INP(I_LNING) + e0), bb = *(const f32x4*)(INP(I_LNINB) + e0);
                const f32x4 h = v[j] * rstd * gg + bb;
                *(f32x4*)(RES + (size_t)row * 1024 + e0) = h;
                const f32x4 sh = *(const LAS f32x4*)(sm + e0), sc = *(const LAS f32x4*)(sm + 1024 + e0);
                const f32x4 uu = h * (sc + 1.0f) + sh;
                v2u o; o.x = pk2(uu[0], uu[1]); o.y = pk2(uu[2], uu[3]);
                *(v2u*)(UB + (size_t)row * 1024 + e0) = o; }
        }
        for (int it = gt_; it < 2 * NG * 32 * 256; it += NGT) {
            const int hp = it & 15, h = (it >> 4) & 15, lag = (it >> 8) & 31, gd = it >> 13;
            const float* cr = INP(I_CRE) + ((size_t)gd * 16 + h) * 64; const float* ci = INP(I_CIM) + ((size_t)gd * 16 + h) * 64;
            float s = 0.f;
            for (int p = 0; p < 64; ++p) { const float ar = AB[((size_t)(gd * 64 + p) * 33 + lag) * 2], ai = AB[((size_t)(gd * 64 + p) * 33 + lag) * 2 + 1];
                const float br = BB[((size_t)(gd * 64 + p) * 16 + hp) * 2], bi = BB[((size_t)(gd * 64 + p) * 16 + hp) * 2 + 1];
                const float xr_ = ar * br - ai * bi, xi_ = ar * bi + ai * br;
                s += cr[p] * xr_ - ci[p] * xi_; }
            KT[it] = s;
        }
        for (int t = gw; t < CTXL; t += NGW) {
            const f32x4* xr = (const f32x4*)(INP(I_CTX) + (size_t)t * 1024) + lane;
            f32x4 v[4]; float s = 0.f;
#pragma unroll
            for (int j = 0; j < 4; ++j) { v[j] = xr[64 * j]; s += (v[j][0] + v[j][1]) + (v[j][2] + v[j][3]); }
            const float mean = wave_sum(s) * (1.f / 1024.f); float s2 = 0.f;
#pragma unroll
            for (int j = 0; j < 4; ++j) { v[j] = v[j] - mean; s2 += (v[j][0] * v[j][0] + v[j][1] * v[j][1]) + (v[j][2] * v[j][2] + v[j][3] * v[j][3]); }
            const float rstd = 1.f / sqrtf(wave_sum(s2) * (1.f / 1024.f) + LN_EPS);
#pragma unroll
            for (int j = 0; j < 4; ++j) { const int e0 = 256 * j + 4 * lane;
                const f32x4 gg = *(const f32x4*)(INP(I_LNING) + e0), bb = *(const f32x4*)(INP(I_LNINB) + e0);
                const f32x4 h = v[j] * rstd * gg + bb;
                const f32x4 sh = *(const LAS f32x4*)(sm + 2048 + e0), sc = *(const LAS f32x4*)(sm + 3072 + e0);
                const f32x4 uu = h * (sc + 1.0f) + sh;
                v2u o; o.x = pk2(uu[0], uu[1]); o.y = pk2(uu[2], uu[3]);
                *(v2u*)(UCB + (size_t)t * 1024 + e0) = o; }
        }
    }
    GRID_BAR();
    DBG_DUMP(1);

    if (PHMASK & (1u << 2))    { PH_BEGIN();
        for (int it = gt_; it < NG * 512 * 96; it += NGT) {
            const int kb = it % 96, nrow = (it / 96) & 511, g = it / (96 * 512), tau = nrow >> 4, h = nrow & 15;
            float o[8];
            if (kb < 64) { const int j = kb >> 1, hp0 = (kb & 1) * 8;
                if (j < tau) { const float* kp = KT + ((size_t)((0 * NG + g) * 32 + (tau - j)) * 16 + h) * 16 + hp0;
#pragma unroll
                    for (int i = 0; i < 8; ++i) o[i] = kp[i]; }
                else if (j > tau) { const float* kp = KT + ((size_t)((1 * NG + g) * 32 + (j - tau)) * 16 + h) * 16 + hp0;
#pragma unroll
                    for (int i = 0; i < 8; ++i) o[i] = kp[i]; }
                else { const float* kf = KT + ((size_t)((0 * NG + g) * 32 + 0) * 16 + h) * 16 + hp0; const float* kb_ = KT + ((size_t)((1 * NG + g) * 32 + 0) * 16 + h) * 16 + hp0;
#pragma unroll
                    for (int i = 0; i < 8; ++i) o[i] = kf[i] + kb_[i] + ((hp0 + i) == h ? INP(I_S5D)[g * 16 + h] : 0.f); }
            } else { const int q = kb - 64, d = q >> 4, part = (q >> 3) & 1, p0 = (q & 7) * 8, gd = d * NG + g, lag = d == 0 ? tau + 1 : 32 - tau;
#pragma unroll
                for (int i = 0; i < 8; ++i) { const int p = p0 + i; const float cr = INP(I_CRE)[((size_t)gd * 16 + h) * 64 + p], ci = INP(I_CIM)[((size_t)gd * 16 + h) * 64 + p];
                    const float ar = AB[((size_t)(gd * 64 + p) * 33 + lag) * 2], ai = AB[((size_t)(gd * 64 + p) * 33 + lag) * 2 + 1];
                    o[i] = part == 0 ? (cr * ar - ci * ai) : -(cr * ai + ci * ar); } }
            v4u w; w.x = pk2(o[0], o[1]); w.y = pk2(o[2], o[3]); w.z = pk2(o[4], o[5]); w.w = pk2(o[6], o[7]);
            *(v4u*)(MYT + ((size_t)(g * 512 + nrow) * 768 + kb * 8)) = w;
        }
        for (int it = gt_; it < NG * 256 * 64; it += NGT) {
            const int kb = it & 63, qq = (it >> 6) & 255, g = it >> 14, j = kb >> 1, hp0 = (kb & 1) * 8, d = qq >> 7, part = (qq >> 6) & 1, p = qq & 63, gd = d * NG + g, lag = d == 0 ? 31 - j : j;
            const float ar = AB[((size_t)(gd * 64 + p) * 33 + lag) * 2], ai = AB[((size_t)(gd * 64 + p) * 33 + lag) * 2 + 1]; float o[8];
#pragma unroll
            for (int i = 0; i < 8; ++i) { const float br = BB[((size_t)(gd * 64 + p) * 16 + hp0 + i) * 2], bi = BB[((size_t)(gd * 64 + p) * 16 + hp0 + i) * 2 + 1]; o[i] = part == 0 ? (ar * br - ai * bi) : (ar * bi + ai * br); }
            v4u w; w.x = pk2(o[0], o[1]); w.y = pk2(o[2], o[3]); w.z = pk2(o[4], o[5]); w.w = pk2(o[6], o[7]);
            *(v4u*)(MET + ((size_t)(g * 256 + qq) * 512 + kb * 8)) = w;
        }
        __syncthreads();
        pg8::Gemm gm{UB, WIN, 1024, 1024, 1024}; pg8::StaticOrder S; S.init(SEQ, 3072, G, b);
        EpiP1 E{BIASP1, ACAT, A1, GT};
#ifdef DBG_ONEUNIT
        for (int ui_ = 0; ui_ < 3; ++ui_) { pg8::OneUnit<pg8::StaticOrder> S1{S, ui_}; pg8::gemm_phase<EpiP1, pg8::OneUnit<pg8::StaticOrder>, true>(lds, gm, S1, E, tid); }
#else
        pg8::gemm_phase<EpiP1, pg8::StaticOrder, true>(lds, gm, S, E, tid);
#endif
    }
    GRID_BAR();
    DBG_DUMP(2);

    if (PHMASK & (1u << 3))    { PH_BEGIN();
        { pg8::Gemm gm{A1, WDFT, 256, 256, 256}; pg8::GroupOrder S; S.init(128, 1, 1, G, b, 0); S.shareB = 1; EpiF1 E{TW, A2};
          pg8::gemm_phase<EpiF1, pg8::GroupOrder, true>(lds, gm, S, E, tid); }
        { pg8::Gemm gm{ACAT, MET, 512, 768, 512}; pg8::GroupOrder S; S.init(NG, 2, 1, G, b, 128); S.shareB = 0; EpiE E{EBUF};
          pg8::gemm_phase<EpiE, pg8::GroupOrder, true>(lds, gm, S, E, tid); }
        { pg8::Gemm gm{UCB, WIN, 256, 1024, 1024}; pg8::KSplitOrder S; S.init(2, 4, 256, G, b, 192); EpiPcs E{PCS4};
          pg8::gemm_phase<EpiPcs, pg8::KSplitOrder, true>(lds, gm, S, E, tid); }
    }
    GRID_BAR();
    DBG_DUMP(3);

    if (PHMASK & (1u << 4))    { PH_BEGIN();
        { pg8::Gemm gm{A2, WDFT, 256, 256, 256}; pg8::GroupOrder S; S.init(128, 1, 1, G, b, 0); S.shareB = 1; EpiF2 E{ZR, ZP};
          pg8::gemm_phase<EpiF2, pg8::GroupOrder, true>(lds, gm, S, E, tid); }
        {
            const int nb = G < 256 ? G : 128, bi = G < 256 ? b : b - 128;
            LAS float* LS = (LAS float*)lds;
            LAS float* SI = LS + 24 * 64;
            if (bi >= 0)
            for (int it = bi; it < 128; it += nb) {
                const int cl = tid & 31, seg = tid >> 5;
                const int ch = it * 32 + cl, p = ch & 63, g = (ch >> 6) & 31, d = ch >> 11, gd = d * NG + g;
                const float* abp = AB + (size_t)(gd * 64 + p) * 66;
                const float Ar = abp[64], Ai = abp[65];
                float er[32], ei[32];
#pragma unroll
                for (int i = 0; i < 32; ++i) { const int c = d == 0 ? seg * 32 + i : NCH - 1 - (seg * 32 + i);
                    er[i] = EBUF[(size_t)(g * NCH + c) * 256 + d * 128 + p]; ei[i] = EBUF[(size_t)(g * NCH + c) * 256 + d * 128 + 64 + p]; }
                float xr = 0.f, xi = 0.f;
                if (seg < NCC) {
                    float bbr[16], bbi[16];
#pragma unroll
                    for (int h = 0; h < 16; ++h) { bbr[h] = BB[((size_t)(gd * 64 + p) * 16 + h) * 2]; bbi[h] = BB[((size_t)(gd * 64 + p) * 16 + h) * 2 + 1]; }
                    for (int j = 0; j < 32; ++j) { const int lag = d == 0 ? 31 - j : j; const float ar = abp[2 * lag], ai = abp[2 * lag + 1];
                        const float* up = PCS4 + (size_t)(seg * 32 + j) * 512 + g * 16; float br = 0.f, bi_ = 0.f;
#pragma unroll
                        for (int h4 = 0; h4 < 4; ++h4) { const f32x4 uv = ((*(const f32x4*)(up + 4 * h4) + *(const f32x4*)(up + 131072 + 4 * h4)) + (*(const f32x4*)(up + 262144 + 4 * h4) + *(const f32x4*)(up + 393216 + 4 * h4))) + *(const f32x4*)(INP(I_BIN) + g * 16 + 4 * h4);
#pragma unroll
                            for (int q = 0; q < 4; ++q) { br += bbr[4 * h4 + q] * uv[q]; bi_ += bbi[4 * h4 + q] * uv[q]; } }
                        xr += ar * br - ai * bi_; xi += ar * bi_ + ai * br; }
                }
                float sr = 0.f, si = 0.f;
#pragma unroll
                for (int i = 0; i < 32; ++i) { const float nr = Ar * sr - Ai * si + er[i], ni = Ar * si + Ai * sr + ei[i]; sr = nr; si = ni; }
                __syncthreads();
                LS[((8 + seg) * 32 + cl) * 2] = sr; LS[((8 + seg) * 32 + cl) * 2 + 1] = si;
                if (seg < NCC) { LS[(seg * 32 + cl) * 2] = xr; LS[(seg * 32 + cl) * 2 + 1] = xi; }
                __syncthreads();
                if (seg == 0) {
                    float S_r = 0.f, S_i = 0.f;
                    for (int i = 0; i < NCC; ++i) { const int cc = d == 0 ? i : NCC - 1 - i; const float lr = LS[(cc * 32 + cl) * 2], li = LS[(cc * 32 + cl) * 2 + 1];
                        const float nr = Ar * S_r - Ai * S_i + lr, ni = Ar * S_i + Ai * S_r + li; S_r = nr; S_i = ni; }
                    float Br = Ar, Bi = Ai;
#pragma unroll
                    for (int q = 0; q < 5; ++q) { const float nr = Br * Br - Bi * Bi, ni = 2.f * Br * Bi; Br = nr; Bi = ni; }
                    for (int s = 0; s < 16; ++s) { SI[(s * 32 + cl) * 2] = S_r; SI[(s * 32 + cl) * 2 + 1] = S_i;
                        const float lr = LS[((8 + s) * 32 + cl) * 2], li = LS[((8 + s) * 32 + cl) * 2 + 1];
                        const float nr = Br * S_r - Bi * S_i + lr, ni = Br * S_i + Bi * S_r + li; S_r = nr; S_i = ni; }
                }
                __syncthreads();
                sr = SI[(seg * 32 + cl) * 2]; si = SI[(seg * 32 + cl) * 2 + 1];
#pragma unroll
                for (int i = 0; i < 32; ++i) { const int c = d == 0 ? seg * 32 + i : NCH - 1 - (seg * 32 + i);
                    bf16* ap = ACAT + (size_t)(g * NCH + c) * 768 + 512 + d * 128 + p; ap[0] = (bf16)f2bf(sr); ap[64] = (bf16)f2bf(si);
                    const float nr = Ar * sr - Ai * si + er[i], ni = Ar * si + Ai * sr + ei[i]; sr = nr; si = ni; }
            }
        }
    }
    GRID_BAR();
    DBG_DUMP(4);

    if (PHMASK & (1u << 5))    { PH_BEGIN();
        { pg8::Gemm gm{ACAT, MYT, 768, 768, 768}; pg8::GroupOrder S; S.init(NG, 2, 2, G, b, 0); S.shareB = 0; EpiY5 E{Y5};
          pg8::gemm_phase<EpiY5, pg8::GroupOrder, true>(lds, gm, S, E, tid); }
        if (G < 256 || b >= 128) {
            const int nb = G < 256 ? G : 128, bi = G < 256 ? b : b - 128;
            for (int it = bi * 512 + tid; it < SEQ * 4; it += nb * 512) {
                const int g = it & 3, r = it >> 2, m1 = r >> 7, m2 = r & 127, m1p = m1 > 0 ? 128 - m1 : 0, m2p = m1 > 0 ? 127 - m2 : ((128 - m2) & 127), rp = m1p * 128 + m2p;
                const f32x2 a = *(const f32x2*)(ZP + ((size_t)r * 4 + g) * 2), c = *(const f32x2*)(ZP + ((size_t)rp * 4 + g) * 2);
                ZR[(size_t)r * 512 + g * 128] = (bf16)f2bf(0.5f * (a[0] + c[0])); ZR[(size_t)r * 512 + g * 128 + 64] = (bf16)f2bf(0.5f * (a[1] + c[1]));
            }
        }
    }
    GRID_BAR();
    DBG_DUMP(5);

    if (PHMASK & (1u << 6))    { PH_BEGIN(); pg8::Gemm gm{Y5, WGLU, 512, 512, 512}; pg8::StaticOrder S; S.init(SEQ, 1024, G, b); EpiPair<0> E{Z5, 512, INP(I_BGLU), 512};
      pg8::gemm_phase<EpiPair<0>, pg8::StaticOrder, true>(lds, gm, S, E, tid); }
    GRID_BAR();
    DBG_DUMP(6);

    if (PHMASK & (1u << 7))    { PH_BEGIN(); pg8::Gemm gm{Z5, WBRS, 512, 512, 512}; pg8::StaticOrder S; S.init(SEQ, 1024, G, b); EpiV1 E{V1, GT};
      pg8::gemm_phase<EpiV1, pg8::StaticOrder, true>(lds, gm, S, E, tid); }
    if (PHMASK & (1u << 7))    { PH_BEGIN(); pg8::Gemm gm{ZR, WBRF, 512, 512, 512}; pg8::StaticOrder S; S.init(SEQ, 1024, G, b); EpiV E{V1, GT, INP(I_BBRF), VB};
      pg8::gemm_phase<EpiV, pg8::StaticOrder, true>(lds, gm, S, E, tid); }
    GRID_BAR();
    DBG_DUMP(7);

    if (PHMASK & (1u << 8))    { PH_BEGIN(); pg8::Gemm gm{VB, WOUT, 1024, 1024, 1024}; pg8::StaticOrder S; S.init(SEQ, 1024, G, b); EpiRes E{RES, V1, INP(I_BOUT), MOD + 2 * 1024};
      pg8::gemm_phase<EpiRes, pg8::StaticOrder, true>(lds, gm, S, E, tid); }
    GRID_BAR();
    DBG_DUMP(8);

    if (PHMASK & (1u << 9))    { PH_BEGIN();
        LAS float* urow = (LAS float*)(lds + wave * 16384);
        LAS int* hist = (LAS int*)(lds + LDSCTL_OFF);
        const float* ln1g = INP(I_LN1G); const float* ln1b = INP(I_LN1B);
        const float* sh2 = MOD + 3 * 1024; const float* sc2 = MOD + 4 * 1024;
        for (int it = b; it < 256; it += G) {
            __syncthreads();
            if (tid < 32) hist[tid] = 0;
            __syncthreads();
            for (int half = 0; half < 2; ++half) {
                const int row0 = it * 64 + wave * 8 + half * 4;
#pragma unroll
                for (int i = 0; i < 4; ++i) {
                    float* rp = RES + (size_t)(row0 + i) * 1024; const float* rin = V1 + (size_t)(row0 + i) * 1024;
                    f32x4 v[4]; float s = 0.f;
#pragma unroll
                    for (int j = 0; j < 4; ++j) { v[j] = *(const f32x4*)(rin + 256 * j + 4 * lane); s += (v[j][0] + v[j][1]) + (v[j][2] + v[j][3]); }
                    const float mean = wave_sum(s) * (1.f / 1024.f); float s2 = 0.f;
#pragma unroll
                    for (int j = 0; j < 4; ++j) { v[j] = v[j] - mean; s2 += (v[j][0] * v[j][0] + v[j][1] * v[j][1]) + (v[j][2] * v[j][2] + v[j][3] * v[j][3]); }
                    const float rstd = 1.f / sqrtf(wave_sum(s2) * (1.f / 1024.f) + LN_EPS);
#pragma unroll
                    for (int j = 0; j < 4; ++j) { const int e0 = 256 * j + 4 * lane;
                        const f32x4 h = v[j] * rstd * *(const f32x4*)(ln1g + e0) + *(const f32x4*)(ln1b + e0);
                        *(f32x4*)(rp + e0) = h;
                        const f32x4 uu = h * (*(const f32x4*)(sc2 + e0) + 1.0f) + *(const f32x4*)(sh2 + e0);
                        v2u o; o.x = pk2(uu[0], uu[1]); o.y = pk2(uu[2], uu[3]);
                        *(v2u*)(UB + (size_t)(row0 + i) * 1024 + e0) = o;
                        *(LAS f32x4*)(urow + i * 1024 + e0) = uu; }
                }
                LDS_WAIT(); asm volatile("" ::: "memory");
                const int e = lane & 31, kh = lane >> 5; float a4[4] = {0.f, 0.f, 0.f, 0.f};
                for (int kq = 0; kq < 128; ++kq) {
                    const int kk = kh * 128 + kq;
                    const f32x4 w = *(const f32x4*)(WRI + ((size_t)kk * 32 + e) * 4);
#pragma unroll
                    for (int i = 0; i < 4; ++i) { const f32x4 uv = *(const LAS f32x4*)(urow + i * 1024 + 4 * kk); a4[i] += (uv[0] * w[0] + uv[1] * w[1]) + (uv[2] * w[2] + uv[3] * w[3]); }
                }
                const float br = INP(I_BR)[e];
#pragma unroll
                for (int i = 0; i < 4; ++i) {
                    float lg = a4[i] + __shfl_xor(a4[i], 32) + br;
                    float tv[4]; int ti[4];
#pragma unroll
                    for (int r = 0; r < 4; ++r) {
                        float bv = lg; int bi_ = e;
#pragma unroll
                        for (int o = 1; o < 32; o <<= 1) { const float ov = __shfl_xor(bv, o); const int oi = __shfl_xor(bi_, o); if (ov > bv || (ov == bv && oi < bi_)) { bv = ov; bi_ = oi; } }
                        tv[r] = bv; ti[r] = bi_; if (e == bi_) lg = -3.0e38f;
                    }
                    const float e1 = __expf(tv[1] - tv[0]), e2 = __expf(tv[2] - tv[0]), e3 = __expf(tv[3] - tv[0]), inv = 1.0f / (1.0f + e1 + e2 + e3);
                    if (lane == 0) { const int row = row0 + i;
                        *(int4*)(EID + (size_t)row * 4) = make_int4(ti[0], ti[1], ti[2], ti[3]);
                        *(f32x4*)(GATE + (size_t)row * 4) = (f32x4){inv, e1 * inv, e2 * inv, e3 * inv};
                        __hip_atomic_fetch_add(&hist[ti[0]], 1, __ATOMIC_RELAXED, __HIP_MEMORY_SCOPE_WORKGROUP); __hip_atomic_fetch_add(&hist[ti[1]], 1, __ATOMIC_RELAXED, __HIP_MEMORY_SCOPE_WORKGROUP); __hip_atomic_fetch_add(&hist[ti[2]], 1, __ATOMIC_RELAXED, __HIP_MEMORY_SCOPE_WORKGROUP); __hip_atomic_fetch_add(&hist[ti[3]], 1, __ATOMIC_RELAXED, __HIP_MEMORY_SCOPE_WORKGROUP); }
                }
                LDS_WAIT(); asm volatile("" ::: "memory");
            }
            __syncthreads();
            if (tid < 32) HIST[it * 32 + tid] = hist[tid];
        }
    }
    GRID_BAR();
    DBG_DUMP(9);

    if (PHMASK & (1u << 10))    { PH_BEGIN();
        LAS int* sh = (LAS int*)lds;
        for (int it = b; it < 256; it += G) {
            __syncthreads();
            if (tid < 32) { int cnt = 0, bef = 0; for (int q = 0; q < 256; ++q) { const int h = HIST[q * 32 + tid]; cnt += h; bef += q < it ? h : 0; } sh[tid] = cnt; sh[64 + tid] = bef; }
            __syncthreads();
            if (tid == 0) { int tb = 0; for (int e = 0; e < 32; ++e) { sh[32 + e] = tb * 256; tb += (sh[e] + 255) >> 8; } sh[96] = tb; }
            __syncthreads();
            if (it < 32) {
                const int e = it, rb = sh[32 + e], cnt = sh[e], nt = (cnt + 255) >> 8;
                for (int q = tid; q < nt; q += NWAVES * 64) TEXP[(rb >> 8) + q] = e;
                for (int q = cnt + tid; q < nt * 256; q += NWAVES * 64) { SROW[rb + q] = -1; SGATE[rb + q] = 0.f; }
                if (e == 0 && tid == 0) TEXP[MAXTILES] = sh[96];
            }
            if (tid < 256) sh[128 + tid] = EID[(size_t)it * 256 + tid];
            __syncthreads();
            if (tid < 256) { const int e = sh[128 + tid]; int rank = 0; for (int q = 0; q < tid; ++q) rank += (sh[128 + q] == e) ? 1 : 0;
                const int dest = sh[32 + e] + sh[64 + e] + rank; sh[384 + tid] = dest;
                SROW[dest] = it * 256 + tid; SGATE[dest] = GATE[(size_t)it * 256 + tid]; }
            __syncthreads();
            for (int q = wave; q < 256; q += NWAVES) {
                const int row = it * 64 + (q >> 2), dest = sh[384 + q];
                const v4u* src = (const v4u*)(UB + (size_t)row * 1024); v4u* dst = (v4u*)(XS + (size_t)dest * 1024);
                const v4u x0 = src[lane], x1 = src[64 + lane]; dst[lane] = x0; dst[64 + lane] = x1;
            }
        }
    }
    GRID_BAR();
    DBG_DUMP(10);

    if (PHMASK & (1u << 11))    { PH_BEGIN(); const int ntiles = TEXP[MAXTILES];
      pg8::Gemm gm{XS, WUP, 1024, 1024, 1024}; pg8::MoeOrder<8> S{TEXP, ntiles, G, b}; EpiPair<1> E{ACT, 1024, INP(I_BUP), 1024};
      pg8::gemm_phase<EpiPair<1>, pg8::MoeOrder<8>, true>(lds, gm, S, E, tid); }
    GRID_BAR();
    DBG_DUMP(11);

    if (PHMASK & (1u << 12))    { PH_BEGIN(); const int ntiles = TEXP[MAXTILES];
      pg8::Gemm gm{ACT, WDN, 1024, 1024, 1024}; pg8::MoeOrder<4> S{TEXP, ntiles, G, b}; EpiDown E{Y2, INP(I_BDN), SROW, SGATE};
      pg8::gemm_phase<EpiDown, pg8::MoeOrder<4>, true>(lds, gm, S, E, tid); }
    GRID_BAR();
    DBG_DUMP(12);

    if (PHMASK & (1u << 13))    { PH_BEGIN();
        const float* g2 = MOD + 5 * 1024; const float* ln2g = INP(I_LN2G); const float* ln2b = INP(I_LN2B);
        for (int row = gw; row < SEQ; row += NGW) {
            const int t = row_of_tok(row);
            f32x4 v[4]; float s = 0.f;
#pragma unroll
            for (int j = 0; j < 4; ++j) { const int e0 = 256 * j + 4 * lane;
                f32x4 m = (f32x4){0.f, 0.f, 0.f, 0.f};
#pragma unroll
                for (int k = 0; k < 4; ++k) { const v2u y = *(const v2u*)(Y2 + ((size_t)row * 4 + k) * 1024 + e0);
                    m[0] += bf2f(y.x & 0xffffu); m[1] += bf2f(y.x >> 16); m[2] += bf2f(y.y & 0xffffu); m[3] += bf2f(y.y >> 16); }
                v[j] = *(const f32x4*)(RES + (size_t)row * 1024 + e0) * DN_ALPHA + *(const f32x4*)(g2 + e0) * m;
                s += (v[j][0] + v[j][1]) + (v[j][2] + v[j][3]); }
            const float mean = wave_sum(s) * (1.f / 1024.f); float s2 = 0.f;
#pragma unroll
            for (int j = 0; j < 4; ++j) { v[j] = v[j] - mean; s2 += (v[j][0] * v[j][0] + v[j][1] * v[j][1]) + (v[j][2] * v[j][2] + v[j][3] * v[j][3]); }
            const float rstd = 1.f / sqrtf(wave_sum(s2) * (1.f / 1024.f) + LN_EPS);
#pragma unroll
            for (int j = 0; j < 4; ++j) { const int e0 = 256 * j + 4 * lane;
                *(f32x4*)(((float*)KA[N_IN]) + (size_t)t * 1024 + e0) = v[j] * rstd * *(const f32x4*)(ln2g + e0) + *(const f32x4*)(ln2b + e0); }
        }
    }
#undef GRID_BAR
}

extern "C" void kernel_launch(void* const* d_in, const int* in_sizes, int n_in, void* d_out, int out_size, void* d_ws, size_t ws_size, hipStream_t stream) {
    static int grid = 0;
    if (grid == 0) {
        if (n_in != N_IN || out_size != SEQ * DM || ws_size < WS_END) { fprintf(stderr, "kernel_launch: unexpected problem (n_in %d, out %d, ws %zu)\n", n_in, out_size, ws_size); grid = -1; return; }
        int dev = 0, cus = 0, per_cu = 0;
        if (hipGetDevice(&dev) != hipSuccess || hipDeviceGetAttribute(&cus, hipDeviceAttributeMultiprocessorCount, dev) != hipSuccess) { fprintf(stderr, "kernel_launch: device query failed\n"); grid = -1; return; }
        if (hipFuncSetAttribute((const void*)mk_fwd, hipFuncAttributeMaxDynamicSharedMemorySize, LDS_BYTES) != hipSuccess) { fprintf(stderr, "kernel_launch: hipFuncSetAttribute failed\n"); grid = -1; return; }
        if (hipOccupancyMaxActiveBlocksPerMultiprocessor(&per_cu, (const void*)mk_fwd, NWAVES * 64, LDS_BYTES) != hipSuccess || per_cu < 1) { fprintf(stderr, "kernel_launch: occupancy query says %d\n", per_cu); per_cu = 1; }
        (void)hipGetLastError();
        grid = cus * (per_cu > 1 ? 1 : per_cu);
        if (grid > 256) grid = 256;
    }
    if (grid < 0) return;
    (void)hipMemsetAsync((char*)d_ws + WS_CTL, 0, CTL_ZERO_BYTES, stream);
    Args a{};
    for (int i = 0; i < N_IN; ++i) a.in[i] = (const float*)d_in[i];
    a.out = (float*)d_out; a.ws = (unsigned char*)d_ws;
    void* kargs[] = {&a};
    hipError_t e = hipLaunchCooperativeKernel((const void*)mk_fwd, dim3(grid), dim3(NWAVES * 64), kargs, LDS_BYTES, stream);
    if (e != hipSuccess) fprintf(stderr, "cooperative launch failed: %s (grid %d)\n", hipGetErrorString(e), grid);
}
```
